# Optimizing an MI355X kernel written in HIP

```python
import math
import jax, jax.numpy as jnp
from jax import lax
import numpy as np

D_MODEL = 1024
BATCH = 8
SEQ = 4096
DEPTH = 1

N_META = 16
GDN_HEADS = 8
GDN_DK = 128
GDN_DV = 128
CONV_WIDTH = 4
CHUNK = 64
ATT_HEADS = 8
ATT_KV_HEADS = 2
ATT_HD = 128
ATT_GROUP = ATT_HEADS // ATT_KV_HEADS
IDX_HEADS = 8
IDX_HD = 64
TOPK_MAX = 256
Q_BLOCK = 128
ROPE_THETA = 10000.0
D_FF = 4 * D_MODEL
EPS = 1e-6

GDN_QK_W = GDN_HEADS * GDN_DK
GDN_V_W = GDN_HEADS * GDN_DV
ATT_Q_W = ATT_HEADS * ATT_HD
ATT_KV_W = ATT_KV_HEADS * ATT_HD
SPLITS = (GDN_QK_W, GDN_QK_W, GDN_V_W, GDN_V_W, GDN_HEADS, GDN_HEADS,
          ATT_Q_W, ATT_KV_W, ATT_KV_W, IDX_HEADS * IDX_HD, IDX_HD, IDX_HEADS,
          D_MODEL, D_MODEL)
N_IN = sum(SPLITS)

kernel_name = "hybrid_gdn_dsa_gated_block"


def _rmsnorm(x, g):
    xf = x.astype(jnp.float32)
    y = xf * lax.rsqrt(jnp.mean(xf * xf, axis=-1, keepdims=True) + EPS)
    return (y * g.astype(jnp.float32)).astype(x.dtype)


def _l2norm(x):
    return x * lax.rsqrt(jnp.sum(x * x, axis=-1, keepdims=True) + EPS)


def _rope_tables(pos, dim):
    inv = ROPE_THETA ** (-jnp.arange(0, dim, 2, dtype=jnp.float32) / dim)
    ang = pos.astype(jnp.float32)[:, None] * inv[None, :]
    return jnp.cos(ang), jnp.sin(ang)


def _apply_rope(x, cos, sin):
    half = x.shape[-1] // 2
    xf = x.astype(jnp.float32)
    x1, x2 = xf[..., :half], xf[..., half:]
    c = cos[None, :, None, :]
    s = sin[None, :, None, :]
    return jnp.concatenate([x1 * c - x2 * s, x2 * c + x1 * s], axis=-1).astype(x.dtype)


def _causal_conv(x, w):
    K = w.shape[0]
    T = x.shape[1]
    xp = jnp.pad(x, ((0, 0), (K - 1, 0), (0, 0)))
    y = xp[:, 0:T] * w[0]
    for j in range(1, K):
        y = y + xp[:, j:j + T] * w[j]
    return y


def _gated_delta_rule(q, k, v, beta, g):
    B_, T_, H, dk = q.shape
    dv = v.shape[-1]
    C = CHUNK
    pad = (-N_META) % C
    tail = (-(T_ + pad)) % C

    def padf(a):
        return jnp.pad(a, [(0, 0), (pad, tail)] + [(0, 0)] * (a.ndim - 2))

    q, k, v, beta, g = padf(q), padf(k), padf(v), padf(beta), padf(g)
    N = (T_ + pad + tail) // C

    def vec_chunks(a):
        return a.reshape(B_, N, C, H, a.shape[-1]).transpose(0, 3, 1, 2, 4)

    def sc_chunks(a):
        return a.reshape(B_, N, C, H).transpose(0, 3, 1, 2)

    q, k, v = vec_chunks(q), vec_chunks(k), vec_chunks(v)
    beta, g = sc_chunks(beta), sc_chunks(g)
    gc = jnp.cumsum(g, axis=-1)

    tri_incl = jnp.tril(jnp.ones((C, C), dtype=bool))
    tri_strict = jnp.tril(jnp.ones((C, C), dtype=bool), -1)
    decay = jnp.exp(jnp.where(tri_incl, gc[..., :, None] - gc[..., None, :], -jnp.inf))

    kb = k * beta[..., None]
    A = jnp.where(tri_strict, jnp.einsum('bhncd,bhnsd->bhncs', kb, k) * decay, 0.0)
    eye = jnp.eye(C, dtype=jnp.float32)
    Tm = lax.linalg.triangular_solve(A + eye, jnp.broadcast_to(eye, A.shape),
                                     left_side=True, lower=True, unit_diagonal=True)
    u = jnp.einsum('bhncs,bhnse->bhnce', Tm, v * beta[..., None])
    w = jnp.einsum('bhncs,bhnsd->bhncd', Tm, kb * jnp.exp(gc)[..., None])
    attn = jnp.einsum('bhncd,bhnsd->bhncs', q, k) * decay
    q_dec = q * jnp.exp(gc)[..., None]
    k_tail = k * jnp.exp(gc[..., -1:] - gc)[..., None]
    g_last = jnp.exp(gc[..., -1])

    def to_scan(a):
        return jnp.moveaxis(a, 2, 0)

    xs = (to_scan(q_dec), to_scan(attn), to_scan(u), to_scan(w), to_scan(k_tail), to_scan(g_last))

    def step(S, inp):
        qe, at, u_i, w_i, kt, gl = inp
        v_new = u_i - jnp.einsum('bhcd,bhde->bhce', w_i, S)
        o = jnp.einsum('bhcd,bhde->bhce', qe, S) + jnp.einsum('bhcs,bhse->bhce', at, v_new)
        S = S * gl[..., None, None] + jnp.einsum('bhcd,bhce->bhde', kt, v_new)
        return S, o

    S0 = jnp.zeros((B_, H, dk, dv), jnp.float32)
    _, o = lax.scan(step, S0, xs)
    o = o.transpose(1, 0, 3, 2, 4).reshape(B_, N * C, H, dv)
    return o[:, pad:pad + T_]


def _gdn_branch(q, k, v, z, b_raw, a_raw, conv_w, a_log, dt_bias, norm_w):
    B_, T_, _ = q.shape
    dt = q.dtype
    qkv = jax.nn.silu(_causal_conv(jnp.concatenate([q, k, v], axis=-1), conv_w))
    q, k, v = jnp.split(qkv, [GDN_QK_W, 2 * GDN_QK_W], axis=-1)
    q = q.reshape(B_, T_, GDN_HEADS, GDN_DK).astype(jnp.float32)
    k = k.reshape(B_, T_, GDN_HEADS, GDN_DK).astype(jnp.float32)
    v = v.reshape(B_, T_, GDN_HEADS, GDN_DV).astype(jnp.float32)
    q = _l2norm(q) * (GDN_DK ** -0.5)
    k = _l2norm(k)
    beta = jax.nn.sigmoid(b_raw.astype(jnp.float32))
    g = -jnp.exp(a_log.astype(jnp.float32)) * jax.nn.softplus(a_raw.astype(jnp.float32) + dt_bias.astype(jnp.float32))
    o = _gated_delta_rule(q, k, v, beta, g)
    zf = z.reshape(B_, T_, GDN_HEADS, GDN_DV).astype(jnp.float32)
    o = _rmsnorm(o, norm_w) * jax.nn.silu(zf)
    return o.reshape(B_, T_, GDN_V_W).astype(dt)


def _dsa_branch(q, k, v, qi, ki, wi, rope_att, rope_idx, n_visible):
    B_, T_, _ = q.shape
    cos_a, sin_a = rope_att
    cos_i, sin_i = rope_idx
    q = _apply_rope(q.reshape(B_, T_, ATT_HEADS, ATT_HD), cos_a, sin_a)
    k = _apply_rope(k.reshape(B_, T_, ATT_KV_HEADS, ATT_HD), cos_a, sin_a)
    v = v.reshape(B_, T_, ATT_KV_HEADS, ATT_HD)
    qi = _apply_rope(qi.reshape(B_, T_, IDX_HEADS, IDX_HD), cos_i, sin_i)
    ki = _apply_rope(ki.reshape(B_, T_, 1, IDX_HD), cos_i, sin_i)[:, :, 0]
    wi = wi * ((IDX_HEADS * IDX_HD) ** -0.5)
    kv = jnp.concatenate([k, v], axis=-1)
    topk = min(TOPK_MAX, n_visible // 4)
    nb = -(-T_ // Q_BLOCK)
    Tq = nb * Q_BLOCK

    def to_blocks(a):
        a = jnp.pad(a, [(0, 0), (0, Tq - T_)] + [(0, 0)] * (a.ndim - 2))
        return jnp.moveaxis(a.reshape((B_, nb, Q_BLOCK) + a.shape[2:]), 1, 0)

    key_pos = jnp.arange(T_, dtype=jnp.int32)

    def block(args):
        qb, qib, wib, posb = args
        s = jnp.einsum('bqhd,bsd->bqhs', qib, ki)
        s = jnp.einsum('bqhs,bqh->bqs', jax.nn.relu(s), wib).astype(jnp.float32)
        s = jnp.where(key_pos[None, None, :] <= posb[None, :, None], s, -jnp.inf)
        _, idx = lax.top_k(s, topk)
        kv_sel = jax.vmap(lambda a, i: a[i])(kv, idx)
        k_sel, v_sel = jnp.split(kv_sel, 2, axis=-1)
        qg = qb.reshape(B_, Q_BLOCK, ATT_KV_HEADS, ATT_GROUP, ATT_HD)
        logits = jnp.einsum('bqgrd,bqkgd->bqgrk', qg, k_sel).astype(jnp.float32) * (ATT_HD ** -0.5)
        valid = (idx <= posb[None, :, None])[:, :, None, None, :]
        p = jax.nn.softmax(jnp.where(valid, logits, -jnp.inf), axis=-1).astype(v.dtype)
        o = jnp.einsum('bqgrk,bqkgd->bqgrd', p, v_sel)
        return o.reshape(B_, Q_BLOCK, ATT_Q_W)

    pos_blocks = jnp.arange(Tq, dtype=jnp.int32).reshape(nb, Q_BLOCK)
    out = lax.map(block, (to_blocks(q), to_blocks(qi), to_blocks(wi), pos_blocks))
    return jnp.moveaxis(out, 0, 1).reshape(B_, Tq, ATT_Q_W)[:, :T_]


def setup_inputs(seed: int = 0) -> dict:
    key = jax.random.key(seed)
    ks = jax.random.split(key, 20)
    f32 = jnp.float32

    def nrm(k, shape, scale):
        return jax.random.normal(k, shape, f32) * scale

    def gain(k, shape):
        return 1.0 + 0.02 * jax.random.normal(k, shape, f32)

    dt = jnp.exp(jax.random.uniform(ks[5], (DEPTH, GDN_HEADS), f32, math.log(1e-3), math.log(1e-1)))
    return {
        "x": jax.random.normal(ks[0], (BATCH, SEQ, D_MODEL), f32),
        "meta_tokens": nrm(ks[1], (N_META, D_MODEL), 1.0),
        "pre_mix_norm": gain(ks[2], (DEPTH, D_MODEL)),
        "w_in": nrm(ks[3], (DEPTH, D_MODEL, N_IN), D_MODEL ** -0.5),
        "conv_w": nrm(ks[4], (DEPTH, CONV_WIDTH, 2 * GDN_QK_W + GDN_V_W), CONV_WIDTH ** -0.5),
        "a_log": jnp.log(jax.random.uniform(ks[6], (DEPTH, GDN_HEADS), f32, 1.0, 16.0)),
        "dt_bias": jnp.log(jnp.expm1(dt)),
        "gdn_norm": gain(ks[7], (DEPTH, GDN_DV)),
        "w_branch_gdn": nrm(ks[8], (DEPTH, GDN_V_W, D_MODEL), GDN_V_W ** -0.5),
        "w_branch_dsa": nrm(ks[9], (DEPTH, ATT_Q_W, D_MODEL), ATT_Q_W ** -0.5),
        "w_out": nrm(ks[10], (DEPTH, D_MODEL, D_MODEL), D_MODEL ** -0.5),
        "post_mix_norm": gain(ks[11], (DEPTH, D_MODEL)),
        "pre_mlp_norm": gain(ks[12], (DEPTH, D_MODEL)),
        "w_up": nrm(ks[13], (DEPTH, D_MODEL, D_FF), D_MODEL ** -0.5),
        "w_down": nrm(ks[14], (DEPTH, D_FF, D_MODEL), D_FF ** -0.5),
        "post_mlp_norm": gain(ks[15], (DEPTH, D_MODEL)),
    }


def reference(x, meta_tokens, pre_mix_norm, w_in, conv_w, a_log, dt_bias, gdn_norm,
              w_branch_gdn, w_branch_dsa, w_out, post_mix_norm, pre_mlp_norm, w_up, w_down,
              post_mlp_norm):
    B_, L, _ = x.shape
    meta = jnp.broadcast_to(meta_tokens.astype(x.dtype)[None], (B_, N_META, D_MODEL))
    h = jnp.concatenate([meta, x], axis=1)
    T_ = h.shape[1]
    pos = jnp.arange(T_, dtype=jnp.int32)
    rope_att = _rope_tables(pos, ATT_HD)
    rope_idx = _rope_tables(pos, IDX_HD)
    split_at = [int(i) for i in np.cumsum(SPLITS)[:-1]]

    for l in range(DEPTH):
        n = _rmsnorm(h, pre_mix_norm[l])
        proj = jnp.einsum('btd,dn->btn', n, w_in[l])
        (gq, gk, gv, gz, gb, ga, aq, ak, av, iq, ik, iw, gate_a, gate_b) = jnp.split(proj, split_at, axis=-1)
        y_gdn = _gdn_branch(gq, gk, gv, gz, gb, ga, conv_w[l], a_log[l], dt_bias[l], gdn_norm[l])
        y_dsa = _dsa_branch(aq, ak, av, iq, ik, iw, rope_att, rope_idx, L)
        merged = (jax.nn.sigmoid(gate_a) * jnp.einsum('btv,vd->btd', y_gdn, w_branch_gdn[l])
                  + jax.nn.sigmoid(gate_b) * jnp.einsum('btv,vd->btd', y_dsa, w_branch_dsa[l]))
        mix = jnp.einsum('btd,de->bte', merged, w_out[l])
        h = h + _rmsnorm(mix, post_mix_norm[l])
        n2 = _rmsnorm(h, pre_mlp_norm[l])
        u = jnp.square(jax.nn.relu(jnp.einsum('btd,df->btf', n2, w_up[l])))
        h = h + _rmsnorm(jnp.einsum('btf,fd->btd', u, w_down[l]), post_mlp_norm[l])

    return h[:, N_META:]
```

```cpp
#include <hip/hip_runtime.h>
#include <hip/hip_cooperative_groups.h>
#include <hip/hip_bf16.h>
#include <cstdio>
#include <cstdint>
namespace cg = cooperative_groups;

constexpr int NB = 8, SEQ = 4096, DM = 1024, NMETA = 16, TT = 4112;
constexpr int TP = 4160, PADF = 48, ROW0 = 64;
constexpr int M_ALL = NB * TP;
constexpr int NIN = 8280;
constexpr float EPS = 1e-6f;
constexpr size_t MiB = 1u << 20;
constexpr size_t SLOT = 65 * MiB;
constexpr size_t SLOT_ELEMS = (size_t)M_ALL * 1024;
static_assert(SLOT == SLOT_ELEMS * 2, "slot size");


namespace pg8 {
#define PG8_LAS __attribute__((address_space(3)))
typedef unsigned short bf16_t;
typedef short bf16x8 __attribute__((ext_vector_type(8)));
typedef float f32x4 __attribute__((ext_vector_type(4)));
typedef unsigned u32x4 __attribute__((ext_vector_type(4)));
constexpr int BM = 256, BK = 64, HALF = 128, HTB = HALF * BK * 2  , STAGE_BYTES = 8 * HTB, NXCD = 8, WGM = 8;

__host__ __device__ __forceinline__ int lds_byte(int r, int c) { const int st = (r >> 4) * 2 + (c >> 5), rr = r & 15, cc = c & 31, ob = rr * 64 + cc * 2; return st * 1024 + (ob ^ (((ob >> 9) & 1) << 5)); }
__host__ __device__ __forceinline__ void stage_rc(int b, int& R, int& C) { const int st = b / 1024, sb = b % 1024, swz = sb ^ (((sb >> 9) & 1) << 5); R = (st >> 1) * 16 + swz / 64; C = (st & 1) * 32 + (swz % 64) / 2; }
__host__ __device__ __forceinline__ int perm32(int rho) { const int n = rho >> 4, i = rho & 15; return 8 * (i >> 2) + 4 * n + (i & 3); }


struct Unit { int pm, pn; };
struct Gemm { const bf16_t* A; const bf16_t* Bt; int K; int rowmode; };
__host__ __device__ __forceinline__ int row_base(int pm, int mode) { return mode ? (pm >> 4) * 4160 + 64 + (pm & 15) * 256 : pm * 256; }

struct StaticOrder {
    int nM, nN, nwg, G, c;
    __host__ __device__ void init(int nM_, int nN_, int G_, int c_) { nM = nM_; nN = nN_; nwg = nM * nN; G = G_; c = c_; }
    __host__ __device__ bool next(int i, Unit& u) const {
        const long L = (long)i * G + c; if (L >= nwg) return false;
        int wgid = (int)L; { const int q = nwg / NXCD, r = nwg % NXCD, xcd = wgid % NXCD, off = wgid / NXCD; wgid = (xcd < r ? xcd * (q + 1) : r * (q + 1) + (xcd - r) * q) + off; }
        const int nig = WGM * nN, gid = wgid / nig, fm = gid * WGM, gsz = (nM - fm) < WGM ? (nM - fm) : WGM;
        u.pm = fm + ((wgid % nig) % gsz); u.pn = (wgid % nig) / gsz; return true;
    }
    __device__ __forceinline__ void a_ready(const Unit&) const {}
    __device__ __forceinline__ void done(const Unit&) const {}
};

typedef float f32x2_t __attribute__((ext_vector_type(2)));
typedef __bf16 bf16x2_t __attribute__((ext_vector_type(2)));
__device__ __forceinline__ unsigned cvtpk(float lo, float hi) { f32x2_t v = {lo, hi}; bf16x2_t b = __builtin_convertvector(v, bf16x2_t); return __builtin_bit_cast(unsigned, b); }
__device__ __forceinline__ float bf_lo(unsigned w) { return __uint_as_float(w << 16); }
__device__ __forceinline__ float bf_hi(unsigned w) { return __uint_as_float(w & 0xffff0000u); }

enum { EM_PLAIN = 0, EM_ROPE128 = 1, EM_ROPE64 = 2, EM_SIGMOID = 3, EM_RELU2 = 4, EM_MUL = 5, EM_MULADD = 6 };
struct EpiAux { const float* tc; const float* ts; const bf16_t* a1; const bf16_t* a2; };
template <int MODE>
__device__ __forceinline__ void epi_bf16(const f32x4 (&acc)[2][2][4][2], int rb, bf16_t* dst, int ldc, int col0, int lc, const EpiAux& X) {
#pragma unroll
    for (int ai = 0; ai < 2; ++ai)
#pragma unroll
        for (int m = 0; m < 4; ++m) {
            const int row = rb + ai * 128 + m * 16;
            int pos = 0;
            if (MODE == EM_ROPE128 || MODE == EM_ROPE64) { pos = row % 4160 - 48; pos = pos < 0 ? 0 : pos; }
            f32x4 a00 = acc[ai][0][m][0], a01 = acc[ai][0][m][1], a10 = acc[ai][1][m][0], a11 = acc[ai][1][m][1];
            asm volatile("" : "+v"(a00), "+v"(a01), "+v"(a10), "+v"(a11) :: "memory");
#pragma unroll
            for (int bj = 0; bj < 2; ++bj) {
                f32x4 v0 = bj ? a10 : a00, v1 = bj ? a11 : a01;
                const size_t off = (size_t)row * ldc + col0 + bj * 128;
                if (MODE == EM_ROPE128 || MODE == EM_ROPE64) {
                    const int i0 = (MODE == EM_ROPE128) ? (lc >> 1) : ((lc & 63) >> 1);
                    const int tw = (MODE == EM_ROPE128) ? 64 : 32;
                    const f32x4 c = *(const f32x4*)(X.tc + pos * tw + i0), s = *(const f32x4*)(X.ts + pos * tw + i0);
                    f32x4 r0, r1;
                    r0[0] = v0[0] * c[0] - v0[1] * s[0]; r0[1] = v0[1] * c[0] + v0[0] * s[0];
                    r0[2] = v0[2] * c[1] - v0[3] * s[1]; r0[3] = v0[3] * c[1] + v0[2] * s[1];
                    r1[0] = v1[0] * c[2] - v1[1] * s[2]; r1[1] = v1[1] * c[2] + v1[0] * s[2];
                    r1[2] = v1[2] * c[3] - v1[3] * s[3]; r1[3] = v1[3] * c[3] + v1[2] * s[3];
                    v0 = r0; v1 = r1;
                }
                if (MODE == EM_SIGMOID) {
#pragma unroll
                    for (int e = 0; e < 4; ++e) { v0[e] = __builtin_amdgcn_rcpf(1.0f + __expf(-v0[e])); v1[e] = __builtin_amdgcn_rcpf(1.0f + __expf(-v1[e])); }
                }
                if (MODE == EM_RELU2) {
#pragma unroll
                    for (int e = 0; e < 4; ++e) { const float a = fmaxf(v0[e], 0.f), b = fmaxf(v1[e], 0.f); v0[e] = a * a; v1[e] = b * b; }
                }
                if (MODE == EM_MUL || MODE == EM_MULADD) {
                    const u32x4 gw = *(const u32x4*)(X.a1 + off);
                    v0[0] *= bf_lo(gw.x); v0[1] *= bf_hi(gw.x); v0[2] *= bf_lo(gw.y); v0[3] *= bf_hi(gw.y);
                    v1[0] *= bf_lo(gw.z); v1[1] *= bf_hi(gw.z); v1[2] *= bf_lo(gw.w); v1[3] *= bf_hi(gw.w);
                    if (MODE == EM_MULADD) {
                        const u32x4 tw1 = *(const u32x4*)(X.a2 + off);
                        v0[0] += bf_lo(tw1.x); v0[1] += bf_hi(tw1.x); v0[2] += bf_lo(tw1.y); v0[3] += bf_hi(tw1.y);
                        v1[0] += bf_lo(tw1.z); v1[1] += bf_hi(tw1.z); v1[2] += bf_lo(tw1.w); v1[3] += bf_hi(tw1.w);
                    }
                }
                u32x4 w; w.x = cvtpk(v0[0], v0[1]); w.y = cvtpk(v0[2], v0[3]); w.z = cvtpk(v1[0], v1[1]); w.w = cvtpk(v1[2], v1[3]);
                *(u32x4*)(dst + off) = w;
            }
        }
}

struct EpiG {
    static constexpr bool PERM = true, AFTER_DRAIN = false;
    bf16_t* raw; float* small; const float* cosI; const float* sinI;
    __device__ __forceinline__ void operator()(const f32x4 (&acc)[2][2][4][2], const Unit& u, int wr, int wc, int fr, int fq) const {
        const int rb = row_base(u.pm, 0) + wr * 64 + fr, lc = wc * 32 + 8 * fq;
        if (u.pn < 16) { const EpiAux X{nullptr, nullptr, nullptr, nullptr}; epi_bf16<EM_PLAIN>(acc, rb, raw + (size_t)(u.pn >> 2) * ((size_t)33280 * 1024), 1024, (u.pn & 3) * 256 + lc, lc, X); }
        else {
#pragma unroll
            for (int ai = 0; ai < 2; ++ai)
#pragma unroll
                for (int m = 0; m < 4; ++m) {
                    const int row = rb + ai * 128 + m * 16;
                    f32x4 v0 = acc[ai][0][m][0], v1 = acc[ai][0][m][1];
                    if (wc < 2) {
                        int pos = row % 4160 - 48; pos = pos < 0 ? 0 : pos;
                        const int i0 = lc >> 1;
                        const f32x4 c = *(const f32x4*)(cosI + pos * 32 + i0), s = *(const f32x4*)(sinI + pos * 32 + i0);
                        f32x4 r0, r1;
                        r0[0] = v0[0] * c[0] - v0[1] * s[0]; r0[1] = v0[1] * c[0] + v0[0] * s[0];
                        r0[2] = v0[2] * c[1] - v0[3] * s[1]; r0[3] = v0[3] * c[1] + v0[2] * s[1];
                        r1[0] = v1[0] * c[2] - v1[1] * s[2]; r1[1] = v1[1] * c[2] + v1[0] * s[2];
                        r1[2] = v1[2] * c[3] - v1[3] * s[3]; r1[3] = v1[3] * c[3] + v1[2] * s[3];
                        v0 = r0; v1 = r1;
                    }
                    float* o = small + (size_t)row * 128 + lc;
                    *(f32x4*)o = v0; *(f32x4*)(o + 4) = v1;
                }
        }
    }
};
struct EpiA {
    static constexpr bool PERM = true, AFTER_DRAIN = false;
    bf16_t *aq, *akv, *iq, *ga, *gb; const float *cosA, *sinA, *cosI, *sinI;
    __device__ __forceinline__ void operator()(const f32x4 (&acc)[2][2][4][2], const Unit& u, int wr, int wc, int fr, int fq) const {
        const int rb = row_base(u.pm, 0) + wr * 64 + fr, lc = wc * 32 + 8 * fq, pn = u.pn;
        const EpiAux XA{cosA, sinA, nullptr, nullptr}, XI{cosI, sinI, nullptr, nullptr};
        if (pn < 4) epi_bf16<EM_ROPE128>(acc, rb, aq, 1024, pn * 256 + lc, lc, XA);
        else if (pn == 4) epi_bf16<EM_ROPE128>(acc, rb, akv, 512, lc, lc, XA);
        else if (pn == 5) epi_bf16<EM_PLAIN>(acc, rb, akv, 512, 256 + lc, lc, XA);
        else if (pn < 8) epi_bf16<EM_ROPE64>(acc, rb, iq, 512, (pn - 6) * 256 + lc, lc, XI);
        else if (pn < 12) epi_bf16<EM_SIGMOID>(acc, rb, ga, 1024, (pn - 8) * 256 + lc, lc, XA);
        else epi_bf16<EM_SIGMOID>(acc, rb, gb, 1024, (pn - 12) * 256 + lc, lc, XA);
    }
};
template <int MODE> struct EpiOne {
    static constexpr bool PERM = true, AFTER_DRAIN = false;
    bf16_t* dst; int ldc; EpiAux X; int rowmode;
    __device__ __forceinline__ void operator()(const f32x4 (&acc)[2][2][4][2], const Unit& u, int wr, int wc, int fr, int fq) const {
        const int rb = row_base(u.pm, rowmode) + wr * 64 + fr, lc = wc * 32 + 8 * fq;
        epi_bf16<MODE>(acc, rb, dst, ldc, u.pn * 256 + lc, lc, X);
    }
};


template <class Epi, class Sched, bool ALIGN_EPI = false, bool SP2 = false>
__device__ __forceinline__ void gemm_phase(PG8_LAS unsigned char* lds, const Gemm g, const Sched& S, const Epi& E) {
    const int tid = threadIdx.x, wid = __builtin_amdgcn_readfirstlane(tid >> 6), lane = tid & 63, wr = wid >> 2, wc = wid & 3, fr = lane & 15, fq = lane >> 4;
    const int K = g.K, nt = K / BK;
    unsigned voffA[2], voffB[2];
#pragma unroll
    for (int i = 0; i < 2; ++i) { int R, C; stage_rc(tid * 16 + i * 8192, R, C); const int Rb = Epi::PERM ? ((R & ~31) + perm32(R & 31)) : R;
        voffA[i] = (unsigned)(R * K + C) * 2u; voffB[i] = (unsigned)(Rb * K + C) * 2u; }
    const size_t kstep = (size_t)(BK * 2);
    const size_t hstep = (size_t)HALF * K * 2;
    const size_t tstep = 2 * hstep;
    const unsigned ldsw = (unsigned)wid * 1024u;
    const int aoff = lds_byte(wr * 64 + fr, fq * 8), boff = lds_byte(wc * 32 + fr, fq * 8);
#define PG8_SA(b, h) (((b) * 2 + (h)) * HTB)
#define PG8_SB(b, h) ((4 + (b) * 2 + (h)) * HTB)
#define PG8_STAGE(bufoff, gbase, voff) do { _Pragma("unroll") for (int _i = 0; _i < 2; ++_i) \
        __builtin_amdgcn_global_load_lds((const unsigned*)((const char*)(gbase) + (voff)[_i]), (PG8_LAS unsigned*)(lds + (bufoff) + ldsw + _i * 8192), 16, 0, 0); } while (0)
#define PG8_LDA(dst, b, h) do { _Pragma("unroll") for (int m = 0; m < 4; ++m) _Pragma("unroll") for (int k = 0; k < 2; ++k) dst[m][k] = *(const PG8_LAS bf16x8*)(lds + PG8_SA(b, h) + aoff + m * 2048 + k * 1024); } while (0)
#define PG8_LDB(dst, b, h) do { _Pragma("unroll") for (int n = 0; n < 2; ++n) _Pragma("unroll") for (int k = 0; k < 2; ++k) dst[n][k] = *(const PG8_LAS bf16x8*)(lds + PG8_SB(b, h) + boff + n * 2048 + k * 1024); } while (0)
#define PG8_MMA(ai, bj, At, Bt) do { __builtin_amdgcn_s_setprio(1); _Pragma("unroll") for (int m = 0; m < 4; ++m) _Pragma("unroll") for (int n = 0; n < 2; ++n) _Pragma("unroll") for (int k = 0; k < 2; ++k) \
        acc[ai][bj][m][n] = __builtin_amdgcn_mfma_f32_16x16x32_bf16(Bt[n][k], At[m][k], acc[ai][bj][m][n], 0, 0, 0); __builtin_amdgcn_s_setprio(0); } while (0)
#define PG8_WAIT_V(n) asm volatile("s_waitcnt vmcnt(" #n ")" ::: "memory")
#define PG8_WAIT_L(n) asm volatile("s_waitcnt lgkmcnt(" #n ")" ::: "memory")
#define PG8_BAR __builtin_amdgcn_s_barrier()
#define PG8_SCHED __builtin_amdgcn_sched_barrier(0)
    Unit cur, nxt; int ui = 0;
    if (!S.next(0, cur)) return;
    f32x4 acc[2][2][4][2];
#pragma unroll
    for (int a = 0; a < 2; ++a)
#pragma unroll
        for (int b = 0; b < 2; ++b)
#pragma unroll
            for (int m = 0; m < 4; ++m)
#pragma unroll
                for (int n = 0; n < 2; ++n) acc[a][b][m][n] = (f32x4){0.f, 0.f, 0.f, 0.f};
    bf16x8 At[4][2], B0[2][2], B1[2][2];
    const char* cA = (const char*)g.A + (size_t)row_base(cur.pm, g.rowmode) * K * 2; const char* cB = (const char*)g.Bt + (size_t)cur.pn * tstep;
    S.a_ready(cur);
    if constexpr (SP2) {
        PG8_STAGE(PG8_SB(0, 0), cB, voffB); PG8_STAGE(PG8_SB(0, 1), cB + hstep, voffB); PG8_STAGE(PG8_SA(0, 0), cA, voffA); PG8_STAGE(PG8_SA(0, 1), cA + hstep, voffA);
        if (wr == 1) PG8_BAR;
        PG8_WAIT_V(2); PG8_BAR;
        PG8_STAGE(PG8_SB(1, 0), cB + kstep, voffB); PG8_STAGE(PG8_SA(1, 0), cA + kstep, voffA); PG8_STAGE(PG8_SB(1, 1), cB + hstep + kstep, voffB);
        PG8_WAIT_V(6); PG8_BAR;
    } else {
        PG8_STAGE(PG8_SB(0, 0), cB, voffB); PG8_STAGE(PG8_SA(0, 0), cA, voffA); PG8_STAGE(PG8_SB(0, 1), cB + hstep, voffB); PG8_STAGE(PG8_SA(0, 1), cA + hstep, voffA);
        if (wr == 1) PG8_BAR;
        PG8_WAIT_V(4); PG8_BAR;
        PG8_STAGE(PG8_SB(1, 0), cB + kstep, voffB); PG8_STAGE(PG8_SA(1, 0), cA + kstep, voffA); PG8_STAGE(PG8_SB(1, 1), cB + hstep + kstep, voffB);
        PG8_WAIT_V(6); PG8_BAR;
    }
    for (;;) {
        const bool has_next = S.next(ui + 1, nxt);
        const char* nA = has_next ? (const char*)g.A + (size_t)row_base(nxt.pm, g.rowmode) * K * 2 : cA; const char* nB = has_next ? (const char*)g.Bt + (size_t)nxt.pn * tstep : cB;
        for (int t = 0; t < nt; t += 2) {
            const bool last = (t == nt - 2);
            const char* a1 = cA + (size_t)(t + 1) * kstep;
            const char* a2 = last ? nA : cA + (size_t)(t + 2) * kstep; const char* b2 = last ? nB : cB + (size_t)(t + 2) * kstep;
            const char* a3 = a2 + kstep; const char* b3 = b2 + kstep;
            if (last && has_next) S.a_ready(nxt);
            if constexpr (SP2) {
            PG8_LDB(B0, 0, 0); PG8_LDB(B1, 0, 1); PG8_SCHED; PG8_LDA(At, 0, 0); PG8_STAGE(PG8_SA(1, 1), a1 + hstep, voffA);
            PG8_WAIT_V(8); PG8_WAIT_L(0); PG8_BAR; PG8_MMA(0, 0, At, B0); PG8_MMA(0, 1, At, B1); PG8_BAR; PG8_SCHED;
            PG8_LDA(At, 0, 1); PG8_STAGE(PG8_SB(0, 0), b2, voffB); PG8_STAGE(PG8_SB(0, 1), b2 + hstep, voffB); PG8_STAGE(PG8_SA(0, 0), a2, voffA);
            PG8_WAIT_V(8); PG8_WAIT_L(0); PG8_BAR; PG8_MMA(1, 0, At, B0); PG8_MMA(1, 1, At, B1); PG8_BAR; PG8_SCHED;
            PG8_LDB(B0, 1, 0); PG8_LDB(B1, 1, 1); PG8_SCHED; PG8_LDA(At, 1, 0); PG8_STAGE(PG8_SA(0, 1), a2 + hstep, voffA);
            PG8_WAIT_V(8); PG8_WAIT_L(0); PG8_BAR; PG8_MMA(0, 0, At, B0); PG8_MMA(0, 1, At, B1); PG8_BAR; PG8_SCHED;
            PG8_LDA(At, 1, 1); PG8_STAGE(PG8_SB(1, 0), b3, voffB); PG8_STAGE(PG8_SB(1, 1), b3 + hstep, voffB); PG8_STAGE(PG8_SA(1, 0), a3, voffA);
            PG8_WAIT_V(8); PG8_WAIT_L(0); PG8_BAR; PG8_MMA(1, 0, At, B0); PG8_MMA(1, 1, At, B1); PG8_BAR; PG8_SCHED;
            } else {
            PG8_LDB(B0, 0, 0); PG8_SCHED; PG8_LDA(At, 0, 0); PG8_STAGE(PG8_SA(1, 1), a1 + hstep, voffA);
            PG8_WAIT_L(8); PG8_BAR; PG8_WAIT_L(0); PG8_MMA(0, 0, At, B0); PG8_BAR; PG8_SCHED;
            PG8_LDB(B1, 0, 1); PG8_STAGE(PG8_SB(0, 0), b2, voffB);
            PG8_BAR; PG8_WAIT_L(0); PG8_MMA(0, 1, At, B1); PG8_BAR;
            PG8_LDA(At, 0, 1); PG8_STAGE(PG8_SA(0, 0), a2, voffA);
            PG8_BAR; PG8_WAIT_L(0); PG8_MMA(1, 0, At, B0); PG8_BAR; PG8_SCHED;
            PG8_STAGE(PG8_SB(0, 1), b2 + hstep, voffB);
            PG8_WAIT_V(6); PG8_BAR; PG8_MMA(1, 1, At, B1); PG8_BAR;
            PG8_LDB(B0, 1, 0); PG8_SCHED; PG8_LDA(At, 1, 0); PG8_STAGE(PG8_SA(0, 1), a2 + hstep, voffA);
            PG8_WAIT_L(8); PG8_BAR; PG8_WAIT_L(0); PG8_MMA(0, 0, At, B0); PG8_BAR; PG8_SCHED;
            PG8_LDB(B1, 1, 1); PG8_STAGE(PG8_SB(1, 0), b3, voffB);
            PG8_BAR; PG8_WAIT_L(0); PG8_MMA(0, 1, At, B1); PG8_BAR;
            PG8_LDA(At, 1, 1); PG8_STAGE(PG8_SA(1, 0), a3, voffA);
            PG8_BAR; PG8_WAIT_L(0); PG8_MMA(1, 0, At, B0); PG8_BAR; PG8_SCHED;
            PG8_STAGE(PG8_SB(1, 1), b3 + hstep, voffB);
            PG8_WAIT_V(6); PG8_BAR; PG8_MMA(1, 1, At, B1); PG8_BAR;
            }
        }
        if constexpr (ALIGN_EPI) { if (wr == 0) PG8_BAR; }
        if constexpr (!Epi::AFTER_DRAIN) { E(acc, cur, wr, wc, fr, fq); S.done(cur); }
        if (!has_next) break;
#pragma unroll
        for (int a = 0; a < 2; ++a)
#pragma unroll
            for (int b = 0; b < 2; ++b)
#pragma unroll
                for (int m = 0; m < 4; ++m)
#pragma unroll
                    for (int n = 0; n < 2; ++n) acc[a][b][m][n] = (f32x4){0.f, 0.f, 0.f, 0.f};
        cur = nxt; cA = nA; cB = nB; ++ui;
        if constexpr (ALIGN_EPI) { if (wr == 1) PG8_BAR; }
    }
    PG8_WAIT_V(0);
    if constexpr (!ALIGN_EPI) { if (wr == 0) PG8_BAR; }
    PG8_BAR;
    if constexpr (Epi::AFTER_DRAIN) { E.fused(acc, cur, wr, wc, fr, fq, lds, wid, lane); S.done(cur); }
#undef PG8_SA
#undef PG8_SB
#undef PG8_STAGE
#undef PG8_LDA
#undef PG8_LDB
#undef PG8_MMA
#undef PG8_WAIT_V
#undef PG8_WAIT_L
#undef PG8_BAR
#undef PG8_SCHED
}
}

#define GAS __attribute__((address_space(1)))
#define LAS __attribute__((address_space(3)))
typedef unsigned short bf16;
typedef float f32x4 __attribute__((ext_vector_type(4)));
typedef float f32x16 __attribute__((ext_vector_type(16)));
typedef unsigned u32x4 __attribute__((ext_vector_type(4)));
typedef unsigned u32x2 __attribute__((ext_vector_type(2)));
typedef short bf16x8 __attribute__((ext_vector_type(8)));
typedef unsigned long long u64;
using pg8::cvtpk; using pg8::bf_lo; using pg8::bf_hi;

#define XB_TMO      128
#define XB_XCNT(j)  (256  + 64 * (j))
#define XB_XSUB(j)  (1280 + 64 * (j))
#define XB_XGEN(j)  (2304 + 64 * (j))
#define XB_TOP      3328
#define XB_TOPGEN   3392
#define XCD_BAR_WORDS 3456
#define XB_SPIN_CAP (1u << 18)

__device__ __forceinline__ unsigned xb_ld(unsigned* p)              { return __hip_atomic_load(p, __ATOMIC_RELAXED, __HIP_MEMORY_SCOPE_AGENT); }
__device__ __forceinline__ unsigned xb_add(unsigned* p, unsigned v) { return __hip_atomic_fetch_add(p, v, __ATOMIC_RELAXED, __HIP_MEMORY_SCOPE_AGENT); }
__device__ __forceinline__ unsigned xb_xcc_id() { return (unsigned)__builtin_amdgcn_s_getreg((3 << 11) | 20) & 0xFu; }
#define XB_SPIN(cond, bar) do { unsigned _sp = 0; while (cond) { __builtin_amdgcn_s_sleep(1); \
    if ((++_sp & 255u) == 0u) { if (xb_ld(&(bar)[XB_TMO])) break; if (_sp > XB_SPIN_CAP) { atomicAdd(&(bar)[XB_TMO], 1u); break; } } } } while (0)

struct XcdBarrier {
    unsigned* bar; unsigned x;
    volatile LAS unsigned* st;
};

__device__ __forceinline__ XcdBarrier xcd_barrier_post(unsigned* bar, volatile LAS unsigned* st) {
    XcdBarrier b; b.bar = bar; b.x = xb_xcc_id(); b.st = st;
    if (threadIdx.x == 0) (void)xb_add(&bar[XB_XCNT(b.x)], 1u);
    return b;
}
__device__ __forceinline__ void xcd_barrier_complete(unsigned* bar, unsigned x, unsigned& nloc, unsigned& nx) {
    const unsigned G = gridDim.x * gridDim.y * gridDim.z;
    unsigned sum, cnt, mine, sp = 0u;
    for (;;) {
        sum = 0u; cnt = 0u; mine = 0u;
#pragma unroll
        for (unsigned j = 0; j < 16; ++j) { const unsigned c = xb_ld(&bar[XB_XCNT(j)]); sum += c; cnt += (c > 0u) ? 1u : 0u; mine = (j == x) ? c : mine; }
        if (sum == G) break;
        __builtin_amdgcn_s_sleep(1);
        if ((++sp & 255u) == 0u) { if (xb_ld(&bar[XB_TMO])) break; if (sp > XB_SPIN_CAP) { atomicAdd(&bar[XB_TMO], 1u); break; } }
    }
    nloc = mine > 0u ? mine : 1u; nx = cnt > 0u ? cnt : 1u;
}

__device__ __forceinline__ void xcd_barrier(const XcdBarrier& b) {
    asm volatile("s_waitcnt vmcnt(0)" ::: "memory");
    __syncthreads();
    if (threadIdx.x == 0) {
        unsigned* bar = b.bar;
        __builtin_amdgcn_s_waitcnt(0);
        unsigned nloc = b.st[0], nx = b.st[1];
        if (nloc == 0u) { xcd_barrier_complete(bar, b.x, nloc, nx); b.st[0] = nloc; b.st[1] = nx; }
        const unsigned old = xb_add(&bar[XB_XSUB(b.x)], 1u);
        const unsigned gen = old / nloc;
        if (old + 1u == (gen + 1u) * nloc) {
            __builtin_amdgcn_fence(__ATOMIC_RELEASE, "agent");
            asm volatile("s_waitcnt vmcnt(0)" ::: "memory");
            const unsigned og = xb_add(&bar[XB_TOP], 1u);
            const unsigned tg = og / nx;
            if (og + 1u == (tg + 1u) * nx) xb_add(&bar[XB_TOPGEN], 1u);
            else XB_SPIN(xb_ld(&bar[XB_TOPGEN]) == tg, bar);
            __builtin_amdgcn_fence(__ATOMIC_ACQUIRE, "agent");
            xb_add(&bar[XB_XGEN(b.x)], 1u);
            asm volatile("s_waitcnt vmcnt(0)" ::: "memory");
        } else {
            XB_SPIN(xb_ld(&bar[XB_XGEN(b.x)]) == gen, bar);
            __builtin_amdgcn_fence(__ATOMIC_ACQUIRE, "agent");
            asm volatile("s_waitcnt vmcnt(0)" ::: "memory");
        }
    }
    __syncthreads();
}

constexpr int NWAVES = 8;
constexpr int LDS_BYTES = 147456;
constexpr int N_PHASES = 15;
constexpr int MISC_OFF = LDS_BYTES - 64;
constexpr int CW_BAR = 1024;
constexpr size_t CTL_ZERO_BYTES = 65536;

constexpr size_t WS_CTL = 0;
constexpr size_t TAB_COSA = 1 * MiB, TAB_SINA = TAB_COSA + (size_t)TT * 64 * 4, TAB_COSI = TAB_SINA + (size_t)TT * 64 * 4, TAB_SINI = TAB_COSI + (size_t)TT * 32 * 4;
constexpr size_t WS_BG = 5 * MiB;
constexpr size_t WS_GL = 7 * MiB + 512 * 1024;
constexpr size_t WS_IKB = 8 * MiB;
constexpr size_t WS_WIN = 13 * MiB;
constexpr size_t WS_WG = 30 * MiB, WS_WD = 32 * MiB, WS_WO = 34 * MiB, WS_WUP = 36 * MiB, WS_WDN = 44 * MiB;
constexpr size_t WS_S0 = 52 * MiB;
__host__ __device__ constexpr size_t WS_S(int i) { return WS_S0 + (size_t)i * SLOT; }
constexpr size_t WS_END = WS_S0 + 7 * SLOT;
static_assert(TAB_SINI + (size_t)TT * 32 * 4 <= WS_BG && WS_BG + (size_t)M_ALL * 64 <= WS_GL && WS_GL + 65536 <= WS_IKB && WS_IKB + (size_t)M_ALL * 128 <= WS_WIN && WS_WIN + (size_t)8448 * 2048 <= WS_WG, "ws map");
constexpr size_t DO_D0 = 0;
constexpr size_t DO_SMALL = 65 * MiB;
constexpr size_t DO_BM = 82 * MiB;
static_assert(DO_SMALL + (size_t)M_ALL * 512 <= DO_BM && DO_BM + (size_t)NB * 4096 * 65 * 8 <= 128 * MiB, "d_out scratch map");

struct Args { const float* in[16]; float* out; unsigned char* ws; int ph_lo, ph_hi; };

struct Frame {
    LAS unsigned char* lds;
    int tid, lane, wave, G, gw, NGW;
    const float *x, *meta, *g_pre_mix, *w_in, *conv_w, *a_log, *dt_bias, *gdn_norm, *w_bg, *w_bd, *w_out, *g_post_mix, *g_pre_mlp, *w_up, *w_down, *g_post_mlp;
    float* out; unsigned char* ws; unsigned char* ob;
    float *cosA, *sinA, *cosI, *sinI, *BG, *SMALL, *GL;
    bf16 *IKB, *WIN, *WG, *WD, *WO, *WUP, *WDN;
    u64* BM;
};
__device__ __forceinline__ bf16* slot(const Frame& F, int i) { return (bf16*)(F.ws + WS_S(i)); }

__device__ __forceinline__ float wave_sum(float v) {
#pragma unroll
    for (int o = 1; o < 64; o <<= 1) v += __shfl_xor(v, o);
    return v;
}
__device__ __forceinline__ float wave_max(float v) {
#pragma unroll
    for (int o = 1; o < 64; o <<= 1) v = fmaxf(v, __shfl_xor(v, o));
    return v;
}
#define LDS_WAIT() asm volatile("s_waitcnt lgkmcnt(0)" ::: "memory")

__device__ __forceinline__ int win_src_col(int np) {
    if (np < 4096) return np;
    if (np < 4352) { const int j = np - 4096;
        if (j < 64) return 6160 + (j >> 1) + 32 * (j & 1);
        if (j < 72) return 6224 + (j - 64);
        if (j < 80) return 4096 + (j - 72);
        if (j < 88) return 4104 + (j - 80);
        return -1; }
    const int q = np - 4352;
    if (q < 1024) { const int hh = q >> 7, j = q & 127; return 4112 + hh * 128 + (j >> 1) + 64 * (j & 1); }
    if (q < 1280) { const int r = q - 1024, hh = r >> 7, j = r & 127; return 5136 + hh * 128 + (j >> 1) + 64 * (j & 1); }
    if (q < 1536) return 5392 + (q - 1280);
    if (q < 2048) { const int r = q - 1536, hh = r >> 6, j = r & 63; return 5648 + hh * 64 + (j >> 1) + 32 * (j & 1); }
    if (q < 3072) return 6232 + (q - 2048);
    return 7256 + (q - 3072);
}
template <bool MAP>
__device__ __forceinline__ void p0_transpose_item(const float* W, int K, int N, bf16* WT, LAS float* scr, int item, int nblk, int lane) {
    const int kb = item / nblk, nb = item % nblk, k0 = 64 * kb, n0 = 32 * nb;
    const int nd = n0 + (lane & 31); const int src = MAP ? win_src_col(nd) : nd;
#pragma unroll 8
    for (int i = 0; i < 32; ++i) { const int kk = 2 * i + (lane >> 5); scr[kk * 33 + (lane & 31)] = (src >= 0) ? W[(size_t)(k0 + kk) * N + src] : 0.f; }
    LDS_WAIT(); asm volatile("" ::: "memory");
    const int c = lane & 7;
#pragma unroll
    for (int j = 0; j < 4; ++j) { const int n = (lane >> 3) + 8 * j; const LAS float* s = scr + (8 * c) * 33 + n;
        u32x4 o; o.x = cvtpk(s[0 * 33], s[1 * 33]); o.y = cvtpk(s[2 * 33], s[3 * 33]); o.z = cvtpk(s[4 * 33], s[5 * 33]); o.w = cvtpk(s[6 * 33], s[7 * 33]);
        *(u32x4*)(WT + (size_t)(n0 + n) * K + k0 + 8 * c) = o; }
    LDS_WAIT(); asm volatile("" ::: "memory");
}
__device__ __forceinline__ void rms_row_to_bf16(const float* xrow, const float* gain, bf16* orow, int lane) {
    const f32x4* xr = (const f32x4*)xrow + lane; const f32x4* gr = (const f32x4*)gain + lane;
    f32x4 v[4]; float s = 0.f;
#pragma unroll
    for (int j = 0; j < 4; ++j) { v[j] = xr[64 * j]; s += (v[j].x * v[j].x + v[j].y * v[j].y) + (v[j].z * v[j].z + v[j].w * v[j].w); }
    const float rstd = 1.0f / sqrtf(wave_sum(s) * (1.f / 1024.f) + EPS);
    u32x2* o8 = (u32x2*)orow + lane;
#pragma unroll
    for (int j = 0; j < 4; ++j) { const f32x4 g = gr[64 * j]; u32x2 w; w.x = cvtpk(v[j].x * rstd * g.x, v[j].y * rstd * g.y); w.y = cvtpk(v[j].z * rstd * g.z, v[j].w * rstd * g.w); o8[64 * j] = w; }
}
__device__ __forceinline__ void sincos_d(double x, float& sn, float& cs) {
    const double TWO_PI = 6.283185307179586476925286766559, INV_TWO_PI = 0.15915494309189533576888376337251;
    const double n = __builtin_rint(x * INV_TWO_PI); const double r = x - n * TWO_PI; const double r2 = r * r;
    double ts = 0.0, tc = 0.0, term = 1.0, tsin = 1.0;
#pragma unroll
    for (int k = 0; k < 14; ++k) {
        tc += term; ts += tsin;
        term = -term * r2 / (double)((2 * k + 1) * (2 * k + 2));
        tsin = -tsin * r2 / (double)((2 * k + 2) * (2 * k + 3));
    }
    sn = (float)(r * ts); cs = (float)tc;
}
__device__ __forceinline__ double powi_d(double b, int e) { double r = 1.0; for (int i = 0; i < e; ++i) r *= b; return r; }

__device__ __forceinline__ void p0_prologue(Frame& F) {
    LAS float* scr = (LAS float*)(F.lds + F.wave * 16384);
    const int gw = F.gw, NGW = F.NGW, lane = F.lane;
    constexpr int I_IN = (1024 / 64) * (8448 / 32), I_SQ = (1024 / 64) * (1024 / 32), I_UP = (1024 / 64) * (4096 / 32), I_DN = (4096 / 64) * (1024 / 32);
    constexpr int NITEMS = I_IN + 3 * I_SQ + I_UP + I_DN;
    for (int it = gw; it < NITEMS; it += NGW) {
        int r = it;
        if (r < I_IN) { p0_transpose_item<true>(F.w_in, 1024, NIN, F.WIN, scr, r, 8448 / 32, lane); continue; } r -= I_IN;
        if (r < I_SQ) { p0_transpose_item<false>(F.w_bg, 1024, 1024, F.WG, scr, r, 32, lane); continue; } r -= I_SQ;
        if (r < I_SQ) { p0_transpose_item<false>(F.w_bd, 1024, 1024, F.WD, scr, r, 32, lane); continue; } r -= I_SQ;
        if (r < I_SQ) { p0_transpose_item<false>(F.w_out, 1024, 1024, F.WO, scr, r, 32, lane); continue; } r -= I_SQ;
        if (r < I_UP) { p0_transpose_item<false>(F.w_up, 1024, 4096, F.WUP, scr, r, 128, lane); continue; } r -= I_UP;
        p0_transpose_item<false>(F.w_down, 4096, 1024, F.WDN, scr, r, 32, lane);
    }
    bf16* N = slot(F, 0);
    {   const f32x4* gr = (const f32x4*)F.g_pre_mix + lane;
        const f32x4 g0 = gr[0], g1 = gr[64], g2 = gr[128], g3 = gr[192];
        for (int r0 = gw * 4; r0 < M_ALL; r0 += NGW * 4) {
            f32x4 v[4][4];
#pragma unroll
            for (int k = 0; k < 4; ++k) { const int r = r0 + k, b = r / TP, tt = r % TP - PADF;
                const float* src = (tt < NMETA) ? F.meta + (size_t)(tt < 0 ? 0 : tt) * 1024 : F.x + ((size_t)b * SEQ + (tt - NMETA)) * 1024;
                const f32x4* xr = (const f32x4*)src + lane; v[k][0] = xr[0]; v[k][1] = xr[64]; v[k][2] = xr[128]; v[k][3] = xr[192]; }
#pragma unroll
            for (int k = 0; k < 4; ++k) { const int r = r0 + k, tt = r % TP - PADF;
                float s = 0.f;
#pragma unroll
                for (int j = 0; j < 4; ++j) s += (v[k][j].x * v[k][j].x + v[k][j].y * v[k][j].y) + (v[k][j].z * v[k][j].z + v[k][j].w * v[k][j].w);
                float rstd = 1.0f / sqrtf(wave_sum(s) * (1.f / 1024.f) + EPS);
                if (tt < 0) rstd = 0.f;
                u32x2* o8 = (u32x2*)(N + (size_t)r * 1024) + lane;
                u32x2 w0, w1, w2, w3;
                w0.x = cvtpk(v[k][0].x * rstd * g0.x, v[k][0].y * rstd * g0.y); w0.y = cvtpk(v[k][0].z * rstd * g0.z, v[k][0].w * rstd * g0.w);
                w1.x = cvtpk(v[k][1].x * rstd * g1.x, v[k][1].y * rstd * g1.y); w1.y = cvtpk(v[k][1].z * rstd * g1.z, v[k][1].w * rstd * g1.w);
                w2.x = cvtpk(v[k][2].x * rstd * g2.x, v[k][2].y * rstd * g2.y); w2.y = cvtpk(v[k][2].z * rstd * g2.z, v[k][2].w * rstd * g2.w);
                w3.x = cvtpk(v[k][3].x * rstd * g3.x, v[k][3].y * rstd * g3.y); w3.y = cvtpk(v[k][3].z * rstd * g3.z, v[k][3].w * rstd * g3.w);
                o8[0] = w0; o8[64] = w1; o8[128] = w2; o8[192] = w3;
            }
        }
    }
    const int gt = blockIdx.x * 512 + F.tid, NGT = F.G * 512;
    const double BASE_A = 0.86596432336006535, BASE_I = 0.74989420933245583;
    for (int e = gt; e < TT * 64; e += NGT) { const int pos = e >> 6, i = e & 63; const float inv = (float)powi_d(BASE_A, i); const float ang = (float)pos * inv; float sn, cs; sincos_d((double)ang, sn, cs); F.cosA[e] = cs; F.sinA[e] = sn; }
    for (int e = gt; e < TT * 32; e += NGT) { const int pos = e >> 5, i = e & 31; const float inv = (float)powi_d(BASE_I, i); const float ang = (float)pos * inv; float sn, cs; sincos_d((double)ang, sn, cs); F.cosI[e] = cs; F.sinI[e] = sn; }
}

__device__ __forceinline__ float silu_f(float y) { return y / (1.0f + __expf(-y)); }
__device__ __forceinline__ void g1_unpack16(const u32x4& a, const u32x4& c, float (&v)[16]) {
    v[0] = bf_lo(a.x); v[1] = bf_hi(a.x); v[2] = bf_lo(a.y); v[3] = bf_hi(a.y); v[4] = bf_lo(a.z); v[5] = bf_hi(a.z); v[6] = bf_lo(a.w); v[7] = bf_hi(a.w);
    v[8] = bf_lo(c.x); v[9] = bf_hi(c.x); v[10] = bf_lo(c.y); v[11] = bf_hi(c.y); v[12] = bf_lo(c.z); v[13] = bf_hi(c.z); v[14] = bf_lo(c.w); v[15] = bf_hi(c.w);
}
__device__ __forceinline__ void g1_phase(Frame& F) {
    constexpr int RB = 52, NBLK = M_ALL / RB;
    static_assert(NBLK * RB == M_ALL && TP % RB == 0, "row blocks");
    for (int u = F.gw; u < 3 * NBLK; u += F.NGW) {
        int lane = F.lane; asm volatile("" : "+v"(lane));
        const int X = u / NBLK, blk = u % NBLK, row0 = blk * RB;
        const bf16* src = slot(F, 1) + (size_t)X * SLOT_ELEMS + 16 * lane;
        bf16* dst = ((X == 0) ? slot(F, 5) : (X == 1) ? slot(F, 6) : (bf16*)(F.ob + DO_D0)) + 16 * lane;
        float w0[16], w1[16], w2[16], w3[16];
        {   const float* cw = F.conv_w + X * 1024 + 16 * lane;
#pragma unroll
            for (int i = 0; i < 16; i += 4) { const f32x4 a = *(const f32x4*)(cw + i), bq = *(const f32x4*)(cw + 3072 + i), cq = *(const f32x4*)(cw + 6144 + i), dq = *(const f32x4*)(cw + 9216 + i);
                w0[i] = a.x; w0[i + 1] = a.y; w0[i + 2] = a.z; w0[i + 3] = a.w; w1[i] = bq.x; w1[i + 1] = bq.y; w1[i + 2] = bq.z; w1[i + 3] = bq.w;
                w2[i] = cq.x; w2[i + 1] = cq.y; w2[i + 2] = cq.z; w2[i + 3] = cq.w; w3[i] = dq.x; w3[i + 1] = dq.y; w3[i + 2] = dq.z; w3[i + 3] = dq.w; } }
        float xm3[16], xm2[16], xm1[16];
        {   const int r = row0;
            const int h3 = r >= 3 ? r - 3 : 0, h2 = r >= 2 ? r - 2 : 0, h1 = r >= 1 ? r - 1 : 0;
            const u32x4 a3 = *(const u32x4*)(src + (size_t)h3 * 1024), c3 = *(const u32x4*)(src + (size_t)h3 * 1024 + 8);
            const u32x4 a2 = *(const u32x4*)(src + (size_t)h2 * 1024), c2 = *(const u32x4*)(src + (size_t)h2 * 1024 + 8);
            const u32x4 a1 = *(const u32x4*)(src + (size_t)h1 * 1024), c1 = *(const u32x4*)(src + (size_t)h1 * 1024 + 8);
            g1_unpack16(a3, c3, xm3); g1_unpack16(a2, c2, xm2); g1_unpack16(a1, c1, xm1); }
        u32x4 pa[4], pc[4];
#pragma unroll
        for (int k = 0; k < 4; ++k) { pa[k] = *(const u32x4*)(src + (size_t)(row0 + k) * 1024); pc[k] = *(const u32x4*)(src + (size_t)(row0 + k) * 1024 + 8); }
        for (int rr = 0; rr < RB; rr += 4) {
#pragma unroll
            for (int k = 0; k < 4; ++k) {
                const int r = row0 + rr + k;
                float x0[16]; g1_unpack16(pa[k], pc[k], x0);
                { const int rn = (rr + 4 + k < RB) ? r + 4 : r;
                  pa[k] = *(const u32x4*)(src + (size_t)rn * 1024); pc[k] = *(const u32x4*)(src + (size_t)rn * 1024 + 8); }
                float y[16]; float ss = 0.f;
#pragma unroll
                for (int i = 0; i < 16; ++i) { const float t = w0[i] * xm3[i] + w1[i] * xm2[i] + w2[i] * xm1[i] + w3[i] * x0[i]; y[i] = t * __builtin_amdgcn_rcpf(1.0f + __expf(-t)); ss += y[i] * y[i]; }
#pragma unroll
                for (int i = 0; i < 16; ++i) { xm3[i] = xm2[i]; xm2[i] = xm1[i]; xm1[i] = x0[i]; }
                float sc = 1.f;
                if (X < 2) { ss += __shfl_xor(ss, 1); ss += __shfl_xor(ss, 2); ss += __shfl_xor(ss, 4); sc = 1.0f / sqrtf(ss + EPS); if (X == 0) sc *= 0.08838834764831845f; }
                const int tt = r % TP - PADF;
                if (tt < 0) sc = 0.f;
                u32x4 o0, o1;
                o0.x = cvtpk(y[0] * sc, y[1] * sc); o0.y = cvtpk(y[2] * sc, y[3] * sc); o0.z = cvtpk(y[4] * sc, y[5] * sc); o0.w = cvtpk(y[6] * sc, y[7] * sc);
                o1.x = cvtpk(y[8] * sc, y[9] * sc); o1.y = cvtpk(y[10] * sc, y[11] * sc); o1.z = cvtpk(y[12] * sc, y[13] * sc); o1.w = cvtpk(y[14] * sc, y[15] * sc);
                u32x4* d = (u32x4*)(dst + (size_t)r * 1024); d[0] = o0; d[1] = o1;
            }
        }
    }
    for (int idx = blockIdx.x * 512 + F.tid; idx < M_ALL * 8; idx += F.G * 512) {
        const int r = idx >> 3, hh = idx & 7, tt = r % TP - PADF;
        if (tt < 0) { F.BG[(size_t)r * 16 + hh] = 0.f; F.BG[(size_t)r * 16 + 8 + hh] = 0.f; continue; }
        const float* sm = F.SMALL + (size_t)r * 128;
        const float gb = sm[72 + hh], ga = sm[80 + hh];
        const f32x4 k0 = *(const f32x4*)(sm + 8 * hh), k1 = *(const f32x4*)(sm + 8 * hh + 4);
        const float beta = __builtin_amdgcn_rcpf(1.0f + __expf(-gb));
        const float xx = ga + F.dt_bias[hh];
        const float sp = fmaxf(xx, 0.f) + log1pf(__expf(-fabsf(xx)));
        F.BG[(size_t)r * 16 + hh] = beta; F.BG[(size_t)r * 16 + 8 + hh] = -__expf(F.a_log[hh]) * sp;
        u32x4 o; o.x = cvtpk(k0.x, k0.y); o.y = cvtpk(k0.z, k0.w); o.z = cvtpk(k1.x, k1.y); o.w = cvtpk(k1.z, k1.w);
        *(u32x4*)(F.IKB + ((((size_t)(r / TP) * 130 + (tt >> 5)) * 4 + (hh >> 1)) * 2 + (hh & 1)) * 256 + (tt & 31) * 8) = o;
    }
}

__device__ __forceinline__ void gdn_scan_naive(Frame& F) {
    if (blockIdx.x >= 64) return;
    const int b = blockIdx.x >> 3, h = blockIdx.x & 7, tid = F.tid;
    const int dv = tid >> 2, qd = tid & 3;
    LAS float* buf = (LAS float*)F.lds;
    constexpr int TS = 392, BS = 16 * TS;
    const bf16* QN = slot(F, 5); const bf16* KN = slot(F, 6); const bf16* VS = (const bf16*)(F.ob + DO_D0);
    float* OR = (float*)slot(F, 1);
    const size_t rowbase = (size_t)b * TP + PADF;
    float S[32];
#pragma unroll
    for (int i = 0; i < 32; ++i) S[i] = 0.f;
    const int tl = tid >> 5, seg = tid & 31;
    constexpr int NCH = TT / 16;
    u32x2 rk, rq, rv; float rb_ = 0.f, rg_ = 0.f;
    {   const size_t ro = (rowbase + tl) * 1024 + h * 128 + seg * 4;
        rk = *(const u32x2*)(KN + ro); rq = *(const u32x2*)(QN + ro); rv = *(const u32x2*)(VS + ro);
        if (seg == 0) { rb_ = F.BG[(rowbase + tl) * 16 + h]; rg_ = F.BG[(rowbase + tl) * 16 + 8 + h]; }
        LAS float* d = buf + tl * TS;
        *(LAS f32x4*)(d + seg * 4) = (f32x4){bf_lo(rk.x), bf_hi(rk.x), bf_lo(rk.y), bf_hi(rk.y)};
        *(LAS f32x4*)(d + 128 + seg * 4) = (f32x4){bf_lo(rq.x), bf_hi(rq.x), bf_lo(rq.y), bf_hi(rq.y)};
        *(LAS f32x4*)(d + 256 + seg * 4) = (f32x4){bf_lo(rv.x), bf_hi(rv.x), bf_lo(rv.y), bf_hi(rv.y)};
        if (seg == 0) { d[384] = rb_; d[385] = __expf(rg_); } }
    __syncthreads();
    for (int c = 0; c < NCH; ++c) {
        const bool more = (c + 1 < NCH);
        if (more) { const size_t row = rowbase + (size_t)(c + 1) * 16 + tl; const size_t ro = row * 1024 + h * 128 + seg * 4;
            rk = *(const u32x2*)(KN + ro); rq = *(const u32x2*)(QN + ro); rv = *(const u32x2*)(VS + ro);
            if (seg == 0) { rb_ = F.BG[row * 16 + h]; rg_ = F.BG[row * 16 + 8 + h]; } }
        const LAS float* cb = buf + (c & 1) * BS;
        for (int tk = 0; tk < 16; ++tk) {
            const LAS float* tb = cb + tk * TS;
            const float beta = tb[384], eg = tb[385], vv = tb[256 + dv];
            float kk[32];
#pragma unroll
            for (int i = 0; i < 8; ++i) { const f32x4 t4 = *(const LAS f32x4*)(tb + qd * 32 + 4 * i); kk[4 * i] = t4.x; kk[4 * i + 1] = t4.y; kk[4 * i + 2] = t4.z; kk[4 * i + 3] = t4.w; }
            float ks = 0.f;
#pragma unroll
            for (int i = 0; i < 32; ++i) ks += kk[i] * S[i];
            ks += __shfl_xor(ks, 1); ks += __shfl_xor(ks, 2);
            const float vp = beta * (vv - eg * ks);
#pragma unroll
            for (int i = 0; i < 32; ++i) S[i] = eg * S[i] + kk[i] * vp;
            float o = 0.f;
#pragma unroll
            for (int i = 0; i < 8; ++i) { const f32x4 t4 = *(const LAS f32x4*)(tb + 128 + qd * 32 + 4 * i); o += t4.x * S[4 * i] + t4.y * S[4 * i + 1] + t4.z * S[4 * i + 2] + t4.w * S[4 * i + 3]; }
            o += __shfl_xor(o, 1); o += __shfl_xor(o, 2);
            if (qd == 0) OR[(rowbase + (size_t)c * 16 + tk) * 1024 + h * 128 + dv] = o;
        }
        if (more) { LAS float* d = buf + ((c + 1) & 1) * BS + tl * TS;
            *(LAS f32x4*)(d + seg * 4) = (f32x4){bf_lo(rk.x), bf_hi(rk.x), bf_lo(rk.y), bf_hi(rk.y)};
            *(LAS f32x4*)(d + 128 + seg * 4) = (f32x4){bf_lo(rq.x), bf_hi(rq.x), bf_lo(rq.y), bf_hi(rq.y)};
            *(LAS f32x4*)(d + 256 + seg * 4) = (f32x4){bf_lo(rv.x), bf_hi(rv.x), bf_lo(rv.y), bf_hi(rv.y)};
            if (seg == 0) { d[384] = rb_; d[385] = __expf(rg_); } }
        __syncthreads();
    }
}
typedef float f32x2 __attribute__((ext_vector_type(2)));
constexpr int AMP = 68;
__device__ __forceinline__ void g2_unit(Frame& F, const int item, const int p, LAS float* Am, const int lane, const bool dry) {
    const int r32 = lane & 31, hi = lane >> 5;
    LAS float* gcs = Am + 64 * AMP;
    LAS float* bts = gcs + 64;
    bf16* QN = slot(F, 5); const bf16* KN = slot(F, 6); const bf16* VS = (const bf16*)(F.ob + DO_D0);
    bf16* UT = slot(F, 3); bf16* KT = slot(F, 1); bf16* Wb = slot(F, 2); bf16* ATT = (bf16*)(F.ob + DO_BM);
    const bool isW = p != 0, doQ = p == 0;
    const int b = item / 520, rem = item % 520, h = rem / 65, c = rem % 65;
    const size_t r0 = (size_t)b * TP + 64 * c; const int hc = h * 128;
    {   float g = F.BG[(r0 + lane) * 16 + 8 + h]; const float beta = F.BG[(r0 + lane) * 16 + h];
#pragma unroll
        for (int o = 1; o < 64; o <<= 1) { const float t = __int_as_float(__builtin_amdgcn_ds_bpermute((lane - o) << 2, __float_as_int(g))); if (lane >= o) g += t; }
        gcs[lane] = g; bts[lane] = beta;
        if (doQ && lane == 63) F.GL[item] = __expf(g); }
    LDS_WAIT();
    {
        bf16x8 k0f[8], k1f[8];
        {   const bf16* kp0 = KN + (r0 + r32) * 1024 + hc + 8 * hi; const bf16* kp1 = kp0 + 32 * 1024;
#pragma unroll
            for (int ks = 0; ks < 8; ++ks) { k0f[ks] = *(const bf16x8*)(kp0 + 16 * ks); k1f[ks] = *(const bf16x8*)(kp1 + 16 * ks); } }
        bf16x8 q0f[8], q1f[8];
        if (doQ) { const bf16* qp0 = QN + (r0 + r32) * 1024 + hc + 8 * hi; const bf16* qp1 = qp0 + 32 * 1024;
#pragma unroll
            for (int ks = 0; ks < 8; ++ks) { q0f[ks] = *(const bf16x8*)(qp0 + 16 * ks); q1f[ks] = *(const bf16x8*)(qp1 + 16 * ks); } }
#pragma unroll
        for (int tt = 0; tt < 3; ++tt) {
            const int ti = tt > 0 ? 1 : 0, tj = tt == 2 ? 1 : 0;
            f32x16 acc;
#pragma unroll
            for (int i = 0; i < 16; ++i) acc[i] = 0.f;
#pragma unroll
            for (int ks = 0; ks < 8; ++ks) acc = __builtin_amdgcn_mfma_f32_32x32x16_bf16(ti ? k1f[ks] : k0f[ks], tj ? k1f[ks] : k0f[ks], acc, 0, 0, 0);
            const int j = 32 * tj + r32; const float gcj = gcs[j];
#pragma unroll
            for (int rg = 0; rg < 16; ++rg) {
                const int i = 32 * ti + (rg & 3) + 8 * (rg >> 2) + 4 * hi;
                const float e = __expf(i >= j ? gcs[i] - gcj : 0.f);
                Am[i * AMP + j] = (i > j) ? bts[i] * acc[rg] * e : 0.f;
            }
        }
        if (doQ) {
#pragma unroll
            for (int tt = 0; tt < 3; ++tt) {
                const int ti = tt > 0 ? 1 : 0, tj = tt == 2 ? 1 : 0;
                f32x16 acq;
#pragma unroll
                for (int i = 0; i < 16; ++i) acq[i] = 0.f;
#pragma unroll
                for (int ks = 0; ks < 8; ++ks) acq = __builtin_amdgcn_mfma_f32_32x32x16_bf16(ti ? q1f[ks] : q0f[ks], tj ? k1f[ks] : k0f[ks], acq, 0, 0, 0);
                const int j = 32 * tj + r32; const float gcj = gcs[j];
#pragma unroll
                for (int rg = 0; rg < 16; ++rg) {
                    const int i = 32 * ti + (rg & 3) + 8 * (rg >> 2) + 4 * hi;
                    const float e = __expf(i >= j ? gcs[i] - gcj : 0.f);
                    const float v = (i >= j) ? acq[rg] * e : 0.f; ATT[(size_t)item * 4096 + i * 64 + j] = (bf16)(cvtpk(v, 0.f) & 0xffffu);
                }
            }
        }
    }
    asm volatile("" ::: "memory");
    if (doQ) {
        const u32x4 z = {0u, 0u, 0u, 0u};
        u32x4* d = (u32x4*)(ATT + (size_t)item * 4096 + (lane >> 1) * 64 + 32 + 16 * (lane & 1)); d[0] = z; d[1] = z;
        const float eg = __expf(gcs[lane]);
        u32x4* qp = (u32x4*)(QN + (r0 + lane) * 1024 + hc);
        u32x4 qv[16];
#pragma unroll
        for (int k = 0; k < 16; ++k) qv[k] = qp[k];
#pragma unroll
        for (int k = 0; k < 16; ++k) { u32x4 v = qv[k];
            v.x = cvtpk(bf_lo(v.x) * eg, bf_hi(v.x) * eg); v.y = cvtpk(bf_lo(v.y) * eg, bf_hi(v.y) * eg); v.z = cvtpk(bf_lo(v.z) * eg, bf_hi(v.z) * eg); v.w = cvtpk(bf_lo(v.w) * eg, bf_hi(v.w) * eg);
            if (!dry) qp[k] = v; else asm volatile("" :: "v"(v.x), "v"(v.y), "v"(v.z), "v"(v.w)); }
    }
    asm volatile("" ::: "memory");
    f32x2 x[64];
    {   const bf16* src = (isW ? KN : VS) + r0 * 1024 + hc + 2 * lane;
        const float gl = gcs[63], fW = isW ? 1.f : 0.f;
        unsigned raw[64];
#pragma unroll
        for (int i = 0; i < 64; ++i) raw[i] = *(const unsigned*)(src + (size_t)i * 1024);
        if (isW) {
            u32x4* d0 = (u32x4*)(KT + (size_t)item * 8192 + (2 * lane) * 64); u32x4* d1 = d0 + 8;
#pragma unroll
            for (int k = 0; k < 8; ++k) { float ee[8];
#pragma unroll
                for (int t = 0; t < 8; ++t) ee[t] = __expf(gl - gcs[8 * k + t]);
                u32x4 o0, o1;
                o0.x = cvtpk(bf_lo(raw[8 * k]) * ee[0], bf_lo(raw[8 * k + 1]) * ee[1]); o0.y = cvtpk(bf_lo(raw[8 * k + 2]) * ee[2], bf_lo(raw[8 * k + 3]) * ee[3]);
                o0.z = cvtpk(bf_lo(raw[8 * k + 4]) * ee[4], bf_lo(raw[8 * k + 5]) * ee[5]); o0.w = cvtpk(bf_lo(raw[8 * k + 6]) * ee[6], bf_lo(raw[8 * k + 7]) * ee[7]);
                o1.x = cvtpk(bf_hi(raw[8 * k]) * ee[0], bf_hi(raw[8 * k + 1]) * ee[1]); o1.y = cvtpk(bf_hi(raw[8 * k + 2]) * ee[2], bf_hi(raw[8 * k + 3]) * ee[3]);
                o1.z = cvtpk(bf_hi(raw[8 * k + 4]) * ee[4], bf_hi(raw[8 * k + 5]) * ee[5]); o1.w = cvtpk(bf_hi(raw[8 * k + 6]) * ee[6], bf_hi(raw[8 * k + 7]) * ee[7]);
                d0[k] = o0; d1[k] = o1; }
        }
#pragma unroll
        for (int i = 0; i < 64; ++i) { const float sc = bts[i] * __expf(gcs[i] * fW); x[i] = (f32x2){bf_lo(raw[i]) * sc, bf_hi(raw[i]) * sc}; }
    }
    asm volatile("" ::: "memory");
#pragma unroll
    for (int i = 1; i < 64; ++i) {
        f32x2 s0 = x[i], s1 = {0.f, 0.f};
#pragma unroll
        for (int jg = 0; jg < (i + 3) / 4; ++jg) { const f32x4 a4 = *(const LAS f32x4*)(Am + i * AMP + 4 * jg);
            s0 -= a4.x * x[4 * jg]; s1 -= a4.y * x[4 * jg + 1]; s0 -= a4.z * x[4 * jg + 2]; s1 -= a4.w * x[4 * jg + 3]; }
        x[i] = s0 + s1;
        asm volatile("" ::: "memory");
    }
    if (isW) { bf16* dst = Wb + r0 * 1024 + hc + 2 * lane;
#pragma unroll
        for (int i = 0; i < 64; ++i) *(unsigned*)(dst + (size_t)i * 1024) = cvtpk(x[i].x, x[i].y);
    } else { u32x4* d0 = (u32x4*)(UT + (size_t)item * 8192 + (2 * lane) * 64); u32x4* d1 = d0 + 8;
#pragma unroll
        for (int k = 0; k < 8; ++k) { u32x4 o0, o1;
            o0.x = cvtpk(x[8 * k].x, x[8 * k + 1].x); o0.y = cvtpk(x[8 * k + 2].x, x[8 * k + 3].x); o0.z = cvtpk(x[8 * k + 4].x, x[8 * k + 5].x); o0.w = cvtpk(x[8 * k + 6].x, x[8 * k + 7].x);
            o1.x = cvtpk(x[8 * k].y, x[8 * k + 1].y); o1.y = cvtpk(x[8 * k + 2].y, x[8 * k + 3].y); o1.z = cvtpk(x[8 * k + 4].y, x[8 * k + 5].y); o1.w = cvtpk(x[8 * k + 6].y, x[8 * k + 7].y);
            d0[k] = o0; d1[k] = o1; }
    }
    LDS_WAIT();
}
__device__ __forceinline__ void g2_phase(Frame& F, const bool dry) {
    LAS float* Am = (LAS float*)(F.lds + F.wave * 17920);
    for (int u = F.gw; u < NB * 8 * 65 * 2; u += F.NGW) {
        int lane = F.lane; asm volatile("" : "+v"(lane));
        g2_unit(F, u >> 1, (u + u / F.NGW) & 1, Am, lane, dry);
    }
}

template <int V>
__device__ __forceinline__ void g3_scan(Frame& F) {
    if (blockIdx.x >= 128) return;
    const int bh = blockIdx.x >> 1, dvh = blockIdx.x & 1, b = bh >> 3, h = bh & 7;
    const int tid = F.tid, lane = F.lane, w = F.wave, r32 = lane & 31, hi = lane >> 5;
    const int qrole = w >> 2, mi = (w >> 1) & 1, ni = w & 1, di = w >> 1;
    LAS bf16* Wl = (LAS bf16*)F.lds;
    LAS bf16* Ql = Wl + 64 * 136;
    LAS bf16* Kl = Ql + 64 * 136;
    LAS bf16* Al = Kl + 2 * 128 * 72;
    LAS bf16* Sl = Al + 2 * 64 * 72;
    LAS bf16* Vl = Sl + 2 * 64 * 136;
    LAS float* glv = (LAS float*)(Vl + 64 * 72);
    const bf16* Wg = slot(F, 2); const bf16* Qg = slot(F, 5); const bf16* KTg = slot(F, 1); const bf16* ATg = (const bf16*)(F.ob + DO_BM); const bf16* UTg = slot(F, 3);
    bf16* Og = (bf16*)(F.ob + DO_D0);
    const int hc = h * 128, dvb = 64 * dvh, item0 = bh * 65;
    f32x16 Sa;
#pragma unroll
    for (int i = 0; i < 16; ++i) Sa[i] = 0.f;
    { const u32x4 z = {0u, 0u, 0u, 0u}; for (int xx = tid; xx < 64 * 136 / 8; xx += 512) *(LAS u32x4*)(Sl + 8 * xx) = z; }
    if (tid < 65) glv[tid] = F.GL[item0 + tid];
    u32x4 pA[7], pB[7]; u32x2 uE[4], uO[4];
#define G3_LOAD(SET, cc_) do { const int ccl_ = (cc_) < 65 ? (cc_) : 64; const int item_ = item0 + ccl_; const size_t r0_ = (size_t)b * TP + 64 * ccl_; \
        _Pragma("unroll") for (int k_ = 0; k_ < 7; ++k_) { const int x_ = tid + 512 * k_; const u32x4* p_; \
            if (k_ < 2) p_ = (const u32x4*)(Wg + (r0_ + (x_ >> 4)) * 1024 + hc + 8 * (x_ & 15)); \
            else if (k_ < 4) p_ = (const u32x4*)(Qg + (r0_ + ((x_ - 1024) >> 4)) * 1024 + hc + 8 * (x_ & 15)); \
            else if (k_ < 6) p_ = (const u32x4*)(KTg + (size_t)item_ * 8192 + (x_ - 2048) * 8); \
            else p_ = (const u32x4*)(ATg + (size_t)item_ * 4096 + (x_ - 3072) * 8); \
            SET[k_] = *p_; } } while (0)
#define G3_STORE(SET, nb_) do { \
        _Pragma("unroll") for (int k_ = 0; k_ < 7; ++k_) { const int x_ = tid + 512 * k_; LAS u32x4* d_; \
            if (k_ < 2) d_ = (LAS u32x4*)(Wl + (x_ >> 4) * 136 + 8 * (x_ & 15)); \
            else if (k_ < 4) d_ = (LAS u32x4*)(Ql + ((x_ - 1024) >> 4) * 136 + 8 * (x_ & 15)); \
            else if (k_ < 6) d_ = (LAS u32x4*)(Kl + (nb_) * (128 * 72) + ((x_ - 2048) >> 3) * 72 + 8 * (x_ & 7)); \
            else d_ = (LAS u32x4*)(Al + (nb_) * (64 * 72) + ((x_ - 3072) >> 3) * 72 + 8 * (x_ & 7)); \
            *d_ = SET[k_]; } } while (0)
#define G3_LOADU(SET, cc_) do { const int ccl_ = (cc_) < 65 ? (cc_) : 64; \
        _Pragma("unroll") for (int q = 0; q < 4; ++q) SET[q] = *(const u32x2*)(UTg + (size_t)(item0 + ccl_) * 8192 + (dvb + 32 * ni + r32) * 64 + 32 * mi + 8 * q + 4 * hi); } while (0)
#define G3_STEP(c_, cb_, PNEXT, PLOAD, UCUR) do { const int cc = (c_); const size_t r0 = (size_t)b * TP + 64 * cc; \
        G3_LOAD(PLOAD, cc + 2); \
        f32x16 acc; _Pragma("unroll") for (int i = 0; i < 16; ++i) acc[i] = 0.f; \
        { const LAS bf16* ap = (qrole ? Ql : Wl) + (32 * mi + r32) * 136 + 8 * hi; const LAS bf16* sp = Sl + (cb_) * (64 * 136) + (32 * ni + r32) * 136 + 8 * hi; \
          _Pragma("unroll") for (int ks = 0; ks < 8; ++ks) { const bf16x8 aX = *(const LAS bf16x8*)(ap + 16 * ks); const bf16x8 bS = *(const LAS bf16x8*)(sp + 16 * ks); acc = __builtin_amdgcn_mfma_f32_32x32x16_bf16(aX, bS, acc, 0, 0, 0); } } \
        if (!qrole) { \
            _Pragma("unroll") for (int q = 0; q < 4; ++q) { \
                const float v0 = bf_lo(UCUR[q].x) - acc[4 * q], v1 = bf_hi(UCUR[q].x) - acc[4 * q + 1], v2 = bf_lo(UCUR[q].y) - acc[4 * q + 2], v3 = bf_hi(UCUR[q].y) - acc[4 * q + 3]; \
                u32x2 pk; pk.x = cvtpk(v0, v1); pk.y = cvtpk(v2, v3); \
                *(LAS u32x2*)(Vl + (32 * ni + r32) * 72 + 32 * mi + 8 * q + 4 * hi) = pk; } \
            G3_LOADU(UCUR, cc + 2); } \
        __syncthreads();                                            \
        if (cc + 1 < 65) G3_STORE(PNEXT, (cb_) ^ 1);                \
        { const float gl = glv[cc]; _Pragma("unroll") for (int i = 0; i < 16; ++i) Sa[i] *= gl; } \
        { const LAS bf16* vp = Vl + (32 * ni + r32) * 72 + 8 * hi; const LAS bf16* kp = Kl + (cb_) * (128 * 72) + (32 * di + r32) * 72 + 8 * hi; const LAS bf16* tp = Al + (cb_) * (64 * 72) + (32 * mi + r32) * 72 + 8 * hi; \
          _Pragma("unroll") for (int ks = 0; ks < 4; ++ks) { const bf16x8 bV = *(const LAS bf16x8*)(vp + 16 * ks); const bf16x8 aK = *(const LAS bf16x8*)(kp + 16 * ks); \
              Sa = __builtin_amdgcn_mfma_f32_32x32x16_bf16(aK, bV, Sa, 0, 0, 0); \
              if (qrole) { const bf16x8 aA = *(const LAS bf16x8*)(tp + 16 * ks); acc = __builtin_amdgcn_mfma_f32_32x32x16_bf16(aA, bV, acc, 0, 0, 0); } } } \
        _Pragma("unroll") for (int q = 0; q < 4; ++q) { u32x2 p0; p0.x = cvtpk(Sa[4 * q], Sa[4 * q + 1]); p0.y = cvtpk(Sa[4 * q + 2], Sa[4 * q + 3]); \
            *(LAS u32x2*)(Sl + ((cb_) ^ 1) * (64 * 136) + (32 * ni + r32) * 136 + 32 * di + 8 * q + 4 * hi) = p0; } \
        if (qrole) { _Pragma("unroll") for (int rg = 0; rg < 16; ++rg) { const int i = 32 * mi + (rg & 3) + 8 * (rg >> 2) + 4 * hi; \
            if (!(V & 1)) Og[(r0 + i) * 1024 + hc + dvb + 32 * ni + r32] = (bf16)(cvtpk(acc[rg], 0.f) & 0xffffu); else asm volatile("" :: "v"(acc[rg])); } } \
        __syncthreads();                                            \
    } while (0)
    G3_LOAD(pA, 0); G3_STORE(pA, 0);
    G3_LOAD(pB, 1);
    G3_LOADU(uE, 0); G3_LOADU(uO, 1);
    __syncthreads();
    for (int c = 0; c < 64; c += 2) {
        G3_STEP(c, 0, pB, pA, uE);
        G3_STEP(c + 1, 1, pA, pB, uO);
    }
    G3_STEP(64, 0, pB, pA, uE);
#undef G3_LOAD
#undef G3_STORE
#undef G3_LOADU
#undef G3_STEP
}

__device__ __forceinline__ void ygdn_phase(Frame& F) {
    const int lane = F.lane;
    bf16* Y = (bf16*)(F.ob + DO_D0); const bf16* GZ = slot(F, 4);
    float nw[16];
    { const f32x4* np = (const f32x4*)(F.gdn_norm + 16 * (lane & 7));
#pragma unroll
      for (int i = 0; i < 4; ++i) { const f32x4 t = np[i]; nw[4 * i] = t.x; nw[4 * i + 1] = t.y; nw[4 * i + 2] = t.z; nw[4 * i + 3] = t.w; } }
    for (int q0 = F.gw * 2; q0 < NB * SEQ; q0 += F.NGW * 2) {
        u32x4 oa[2], oc[2], za[2], zc[2];
#pragma unroll
        for (int k = 0; k < 2; ++k) { const int q = q0 + k; const size_t r = (size_t)(q >> 12) * TP + ROW0 + (q & 4095);
            oa[k] = *(const u32x4*)(Y + r * 1024 + 16 * lane); oc[k] = *(const u32x4*)(Y + r * 1024 + 16 * lane + 8);
            za[k] = *(const u32x4*)(GZ + r * 1024 + 16 * lane); zc[k] = *(const u32x4*)(GZ + r * 1024 + 16 * lane + 8); }
#pragma unroll
        for (int k = 0; k < 2; ++k) { const int q = q0 + k; const size_t r = (size_t)(q >> 12) * TP + ROW0 + (q & 4095);
            float o[16], z[16]; g1_unpack16(oa[k], oc[k], o); g1_unpack16(za[k], zc[k], z);
            float ss = 0.f;
#pragma unroll
            for (int i = 0; i < 16; ++i) ss += o[i] * o[i];
            ss += __shfl_xor(ss, 1); ss += __shfl_xor(ss, 2); ss += __shfl_xor(ss, 4);
            const float rs = 1.0f / sqrtf(ss * (1.f / 128.f) + EPS);
            float y[16];
#pragma unroll
            for (int i = 0; i < 16; ++i) y[i] = o[i] * rs * nw[i] * (z[i] * __builtin_amdgcn_rcpf(1.0f + __expf(-z[i])));
            u32x4 w0, w1;
            w0.x = cvtpk(y[0], y[1]); w0.y = cvtpk(y[2], y[3]); w0.z = cvtpk(y[4], y[5]); w0.w = cvtpk(y[6], y[7]);
            w1.x = cvtpk(y[8], y[9]); w1.y = cvtpk(y[10], y[11]); w1.z = cvtpk(y[12], y[13]); w1.w = cvtpk(y[14], y[15]);
            u32x4* d = (u32x4*)(Y + r * 1024 + 16 * lane); d[0] = w0; d[1] = w1;
        }
    }
}

constexpr int SCW = 4160;
__device__ __forceinline__ unsigned f2key(float f) { const unsigned u = __float_as_uint(f); return (u & 0x80000000u) ? ~u : (u | 0x80000000u); }
#define KEYCNT(expr_) do { _Pragma("unroll") for (int i_ = 0; i_ < 65; ++i_) { if ((i_ & 7) == 0 && i_ >= n64) break; cnt += __builtin_popcountll(__ballot(expr_)); } } while (0)
template <int V>
__device__ __forceinline__ void idx_phase(Frame& F) {
    LAS float* sc = (LAS float*)F.lds;
    const int lane = F.lane, w = F.wave, r32 = lane & 31, hi = lane >> 5;
    const bf16* IQ = slot(F, 2) + (size_t)M_ALL * 512;
    const float NEG_INF = -__builtin_inff();
    for (int item = blockIdx.x; item < NB * 512; item += F.G) {
        const int b = item & 7, qb = 511 - (item >> 3);
        const int t0 = NMETA + 8 * qb, tmax = t0 + 7;
        const size_t rowq = (size_t)b * TP + PADF + t0;
        const int nt32 = (tmax >> 5) + 1, n64 = (tmax >> 6) + 1, nt32p = 2 * n64;
        bf16x8 af[2][4]; float wv[2][16];
#pragma unroll
        for (int tile = 0; tile < 2; ++tile) {
            const int tok = tile * 4 + (r32 >> 3), head = r32 & 7;
            const bf16* p = IQ + (rowq + tok) * 512 + head * 64 + 8 * hi;
#pragma unroll
            for (int ks = 0; ks < 4; ++ks) af[tile][ks] = *(const bf16x8*)(p + 16 * ks);
#pragma unroll
            for (int j = 0; j < 4; ++j) { const f32x4 t4 = *(const f32x4*)(F.SMALL + (rowq + tile * 4 + j) * 128 + 64 + 4 * hi); wv[tile][4 * j] = t4.x; wv[tile][4 * j + 1] = t4.y; wv[tile][4 * j + 2] = t4.z; wv[tile][4 * j + 3] = t4.w; }
        }
        const bf16* kbase = F.IKB + (size_t)b * 130 * 2048 + hi * 256 + r32 * 8;
#define IDX_LOADT(SET, kt_) do { const int kn_ = (kt_) < nt32 ? (kt_) : nt32 - 1; \
            _Pragma("unroll") for (int ks = 0; ks < 4; ++ks) SET[ks] = *(const bf16x8*)(kbase + (size_t)kn_ * 2048 + ks * 512); } while (0)
#define IDX_RELU(x_) __int_as_float(max(__float_as_int(x_), 0))
#define IDX_TILE(SET, kt_) do { const int ktc_ = (kt_); if (ktc_ < nt32p) { const int s = ktc_ * 32 + r32; \
            if (ktc_ < nt32) { \
                f32x16 a0, a1; \
                _Pragma("unroll") for (int i = 0; i < 16; ++i) { a0[i] = 0.f; a1[i] = 0.f; } \
                _Pragma("unroll") for (int ks = 0; ks < 4; ++ks) { a0 = __builtin_amdgcn_mfma_f32_32x32x16_bf16(af[0][ks], SET[ks], a0, 0, 0, 0); a1 = __builtin_amdgcn_mfma_f32_32x32x16_bf16(af[1][ks], SET[ks], a1, 0, 0, 0); } \
                float pv_[4]; \
                _Pragma("unroll") for (int j = 0; j < 4; ++j) { \
                    const float x0_ = wv[0][4 * j] * IDX_RELU(a0[4 * j]) + wv[0][4 * j + 1] * IDX_RELU(a0[4 * j + 1]) + wv[0][4 * j + 2] * IDX_RELU(a0[4 * j + 2]) + wv[0][4 * j + 3] * IDX_RELU(a0[4 * j + 3]); \
                    const float x1_ = wv[1][4 * j] * IDX_RELU(a1[4 * j]) + wv[1][4 * j + 1] * IDX_RELU(a1[4 * j + 1]) + wv[1][4 * j + 2] * IDX_RELU(a1[4 * j + 2]) + wv[1][4 * j + 3] * IDX_RELU(a1[4 * j + 3]); \
                      \
                    const auto rr_ = __builtin_amdgcn_permlane32_swap(__float_as_uint(x0_), __float_as_uint(x1_), false, false); \
                    pv_[j] = __uint_as_float(rr_[0]) + __uint_as_float(rr_[1]); } \
                _Pragma("unroll") for (int j = 0; j < 4; ++j) { const int tok = hi * 4 + j; sc[tok * SCW + s] = (s > t0 + tok) ? NEG_INF : pv_[j]; } \
            } else { \
                _Pragma("unroll") for (int j = 0; j < 4; ++j) sc[(hi * 4 + j) * SCW + s] = NEG_INF; \
            } } } while (0)
        if (!(V & 1)) {
            bf16x8 bA[4], bB[4], bC[4];
            IDX_LOADT(bA, w); IDX_LOADT(bB, w + 8);
            if (V & 4) IDX_LOADT(bC, w + 16);
            for (int kt = w; kt < nt32p; kt += 24) {
                if (!(V & 4)) IDX_LOADT(bC, kt + 16); IDX_TILE(bA, kt);
                if (!(V & 4)) IDX_LOADT(bA, kt + 24); IDX_TILE(bB, kt + 8);
                if (!(V & 4)) IDX_LOADT(bB, kt + 32); IDX_TILE(bC, kt + 16);
            }
        }
#undef IDX_LOADT
#undef IDX_RELU
#undef IDX_TILE
        __syncthreads();
        if (!(V & 2))
        {
            const int t = t0 + w;
            u64 myword = 0ull, word64 = 0ull;
            if (t + 1 <= 256) {
                const int nb = t + 1 - 64 * lane; myword = nb >= 64 ? ~0ull : (nb > 0 ? ((1ull << nb) - 1ull) : 0ull);
            } else {
                unsigned key[65];
#pragma unroll
                for (int i = 0; i < 65; ++i) { const float v = sc[w * SCW + 64 * i + lane]; key[i] = f2key(v) & (unsigned)-(int)(i < n64); }
                unsigned prefix = 0u; bool exact = false;
                for (int bit = 31; bit >= 0; --bit) {
                    const unsigned cand = prefix | (1u << bit); int cnt = 0;
                    KEYCNT(key[i_] >= cand);
                    if (cnt >= 256) { prefix = cand; if (cnt == 256) { exact = true; break; } }
                }
                int need = 0;
                if (!exact) { int cnt = 0; KEYCNT(key[i_] >= prefix); if (cnt == 256) exact = true; else { cnt = 0; KEYCNT(key[i_] > prefix); need = 256 - cnt; } }
#pragma unroll
                for (int i = 0; i < 65; ++i) {
                    u64 m;
                    if (exact) m = __ballot(key[i] >= prefix);
                    else {
                        m = __ballot(key[i] > prefix); u64 eq = __ballot(key[i] == prefix);
                        if (need > 0 && eq != 0ull) { const int c = __builtin_popcountll(eq);
                            if (c <= need) { m |= eq; need -= c; }
                            else { u64 tk = 0ull; for (int z = 0; z < need; ++z) { const u64 lb = eq & (0ull - eq); tk |= lb; eq ^= lb; } m |= tk; need = 0; } }
                    }
                    if (i < 64) myword = (lane == i) ? m : myword; else word64 = m;
                }
            }
            u64* dst = F.BM + ((size_t)b * SEQ + (t - NMETA)) * 65;
            dst[lane] = myword; if (lane == 0) dst[64] = word64;
        }
        __syncthreads();
    }
}

__device__ __forceinline__ void attn_naive(Frame& F) {
    const int lane = F.lane, w = F.wave;
    LAS float* qf = (LAS float*)(F.lds + w * 13312);
    LAS float* P = qf + 1024;
    LAS int* list = (LAS int*)(P + 2048);
    const bf16* AQ = slot(F, 1); const bf16* AKV = slot(F, 2); bf16* Y = slot(F, 6);
    const float NEG_INF = -__builtin_inff();
    for (int qi = F.gw; qi < NB * SEQ; qi += F.NGW) {
        const int b = qi >> 12, j = qi & 4095;
        const size_t row = (size_t)b * TP + ROW0 + j; const size_t krow0 = (size_t)b * TP + PADF;
        {   const u32x4 a = *(const u32x4*)(AQ + row * 1024 + 16 * lane), c = *(const u32x4*)(AQ + row * 1024 + 16 * lane + 8);
            LAS f32x4* d = (LAS f32x4*)(qf + 16 * lane);
            d[0] = (f32x4){bf_lo(a.x), bf_hi(a.x), bf_lo(a.y), bf_hi(a.y)}; d[1] = (f32x4){bf_lo(a.z), bf_hi(a.z), bf_lo(a.w), bf_hi(a.w)};
            d[2] = (f32x4){bf_lo(c.x), bf_hi(c.x), bf_lo(c.y), bf_hi(c.y)}; d[3] = (f32x4){bf_lo(c.z), bf_hi(c.z), bf_lo(c.w), bf_hi(c.w)}; }
        const u64* bm = F.BM + (size_t)qi * 65;
        int nsel = 0;
        for (int i = 0; i < 65; ++i) { const u64 m = bm[i]; if ((m >> lane) & 1ull) list[nsel + __builtin_popcountll(m & ((1ull << lane) - 1ull))] = 64 * i + lane; nsel += __builtin_popcountll(m); }
        nsel = nsel > 256 ? 256 : nsel;
        LDS_WAIT();
        for (int rr = 0; rr < 4; ++rr) {
            const int jj = 64 * rr + lane; const bool valid = jj < nsel; const int s = valid ? list[jj] : 0;
            const bf16* kp = AKV + (krow0 + s) * 512;
            float a[8];
#pragma unroll
            for (int i = 0; i < 8; ++i) a[i] = 0.f;
#pragma unroll 4
            for (int c = 0; c < 16; ++c) {
                const u32x4 k0 = *(const u32x4*)(kp + 8 * c), k1 = *(const u32x4*)(kp + 128 + 8 * c);
                const float kf0[8] = {bf_lo(k0.x), bf_hi(k0.x), bf_lo(k0.y), bf_hi(k0.y), bf_lo(k0.z), bf_hi(k0.z), bf_lo(k0.w), bf_hi(k0.w)};
                const float kf1[8] = {bf_lo(k1.x), bf_hi(k1.x), bf_lo(k1.y), bf_hi(k1.y), bf_lo(k1.z), bf_hi(k1.z), bf_lo(k1.w), bf_hi(k1.w)};
#pragma unroll
                for (int hh = 0; hh < 4; ++hh) {
                    const f32x4 qa = *(const LAS f32x4*)(qf + hh * 128 + 8 * c), qb = *(const LAS f32x4*)(qf + hh * 128 + 8 * c + 4);
                    a[hh] += kf0[0] * qa.x + kf0[1] * qa.y + kf0[2] * qa.z + kf0[3] * qa.w + kf0[4] * qb.x + kf0[5] * qb.y + kf0[6] * qb.z + kf0[7] * qb.w;
                    const f32x4 qc = *(const LAS f32x4*)(qf + (4 + hh) * 128 + 8 * c), qd = *(const LAS f32x4*)(qf + (4 + hh) * 128 + 8 * c + 4);
                    a[4 + hh] += kf1[0] * qc.x + kf1[1] * qc.y + kf1[2] * qc.z + kf1[3] * qc.w + kf1[4] * qd.x + kf1[5] * qd.y + kf1[6] * qd.z + kf1[7] * qd.w;
                }
            }
#pragma unroll
            for (int hd = 0; hd < 8; ++hd) P[hd * 256 + jj] = valid ? a[hd] * 0.08838834764831845f : NEG_INF;
        }
        LDS_WAIT();
#pragma unroll
        for (int hd = 0; hd < 8; ++hd) {
            float v0 = P[hd * 256 + lane], v1 = P[hd * 256 + 64 + lane], v2 = P[hd * 256 + 128 + lane], v3 = P[hd * 256 + 192 + lane];
            const float mx = wave_max(fmaxf(fmaxf(v0, v1), fmaxf(v2, v3)));
            v0 = __expf(v0 - mx); v1 = __expf(v1 - mx); v2 = __expf(v2 - mx); v3 = __expf(v3 - mx);
            const float inv = 1.0f / wave_sum((v0 + v1) + (v2 + v3));
            P[hd * 256 + lane] = v0 * inv; P[hd * 256 + 64 + lane] = v1 * inv; P[hd * 256 + 128 + lane] = v2 * inv; P[hd * 256 + 192 + lane] = v3 * inv;
        }
        LDS_WAIT();
        const int g = lane >> 5, d0 = (lane & 31) * 4;
        float o[4][4];
#pragma unroll
        for (int hh = 0; hh < 4; ++hh) { o[hh][0] = 0.f; o[hh][1] = 0.f; o[hh][2] = 0.f; o[hh][3] = 0.f; }
#pragma unroll 4
        for (int jj = 0; jj < nsel; ++jj) {
            const int s = list[jj];
            const u32x2 vv = *(const u32x2*)(AKV + (krow0 + s) * 512 + 256 + g * 128 + d0);
            const float v0 = bf_lo(vv.x), v1 = bf_hi(vv.x), v2 = bf_lo(vv.y), v3 = bf_hi(vv.y);
#pragma unroll
            for (int hh = 0; hh < 4; ++hh) { const float p = P[(4 * g + hh) * 256 + jj]; o[hh][0] += p * v0; o[hh][1] += p * v1; o[hh][2] += p * v2; o[hh][3] += p * v3; }
        }
#pragma unroll
        for (int hh = 0; hh < 4; ++hh) { u32x2 ow; ow.x = cvtpk(o[hh][0], o[hh][1]); ow.y = cvtpk(o[hh][2], o[hh][3]); *(u32x2*)(Y + row * 1024 + (4 * g + hh) * 128 + d0) = ow; }
        LDS_WAIT();
    }
}

namespace att {
constexpr int D = 128, QS = 1024, KVS = 512, OS = 1024;
constexpr bool WSKIP = false;
constexpr float THR = 8.f;
constexpr float SCALE = 0.08838834764831845f;
constexpr int NW = 8, QBLK = 32, KVBLK = 64, QB = NW * QBLK;
constexpr int SHM_V = KVBLK * D * 2, SHM_K = KVBLK * D * 2;
constexpr int LDS_BYTES = 2 * SHM_V + 2 * SHM_K + NW * 64 * 4;
using bf16 = __hip_bfloat16;
typedef short bf16x8 __attribute__((ext_vector_type(8)));
typedef short s16x4 __attribute__((ext_vector_type(4)));
typedef float f32x16 __attribute__((ext_vector_type(16)));
typedef float f32x4 __attribute__((ext_vector_type(4)));
typedef unsigned u32x4 __attribute__((ext_vector_type(4)));
template <class A, class Bt> struct same_t { static constexpr bool v = false; };
template <class A> struct same_t<A, A> { static constexpr bool v = true; };
#define KSWZ(row, colB) ((row) * 256 + ((colB) ^ (((row) & 7) << 4)))
#define SBAR() __builtin_amdgcn_sched_barrier(0)
__device__ __forceinline__ int v_st(int k, int c) { const int kk = (k & ~0xC) | ((k & 4) << 1) | ((k & 8) >> 1); return ((kk >> 3) * 4 + (c >> 5)) * 512 + ((kk & 7) * 32 + (c & 31)) * 2; }
__device__ __forceinline__ int v_rd_base(int lane) { return ((lane & 3) << 3) | (((lane >> 2) & 3) << 6) | (((lane >> 4) & 1) << 5) | (((lane >> 5) & 1) << 8); }
constexpr int v_rd_off(int d0, int ks, int half) { return d0 * 512 + ks * 4096 + half * 2048; }
__device__ __forceinline__ int crow(int r, int hi) { return (r & 3) + 8 * (r >> 2) + 4 * hi; }
__device__ __forceinline__ unsigned cvtpk(float lo, float hi) {
    unsigned r; asm volatile("v_cvt_pk_bf16_f32 %0, %1, %2" : "=v"(r) : "v"(lo), "v"(hi)); return r;
}
__device__ __forceinline__ bf16x8 pack8(f32x4 a, f32x4 b) {
    u32x4 w = {cvtpk(a[0], a[1]), cvtpk(a[2], a[3]), cvtpk(b[0], b[1]), cvtpk(b[2], b[3])};
    return *reinterpret_cast<bf16x8*>(&w);
}
template <class T> __device__ __forceinline__ bf16x8 load8(const T* p) {
    if constexpr (same_t<T, float>::v) { return pack8(*(const f32x4*)p, *(const f32x4*)(p + 4)); }
    else { return *reinterpret_cast<const bf16x8*>(p); }
}
__device__ __forceinline__ void mask_tile(f32x16& p0, f32x16& p1, int dq, unsigned W) {
    const float NEG = -__builtin_inff();
#pragma unroll
    for (int r = 0; r < 16; ++r) {
        const int c = (r & 3) + 8 * (r >> 2);
        if ((unsigned)(dq - c) >= W) p0[r] = NEG;
        if ((unsigned)(dq - c - 32) >= W) p1[r] = NEG;
    }
}
__device__ __forceinline__ void mask_bits(f32x16& p0, f32x16& p1, unsigned long long word, int hi) {
    const float NEG = -__builtin_inff();
    const unsigned lo = (unsigned)(word >> (4 * hi)), up = (unsigned)(word >> (32 + 4 * hi));
#pragma unroll
    for (int r = 0; r < 16; ++r) {
        const unsigned bit = 1u << ((r & 3) + 8 * (r >> 2));
        if (!(lo & bit)) p0[r] = NEG;
        if (!(up & bit)) p1[r] = NEG;
    }
}
__device__ __forceinline__ void partialSM(f32x16& p0, f32x16& p1, float& m_reg, float& mn, float& alpha) {
    float pmax = p0[0]; for (int r = 1; r < 16; ++r) pmax = fmaxf(pmax, p0[r]); for (int r = 0; r < 16; ++r) pmax = fmaxf(pmax, p1[r]);
    { auto rr = __builtin_amdgcn_permlane32_swap(__float_as_uint(pmax), __float_as_uint(pmax), false, false);
      pmax = fmaxf(__uint_as_float(rr[0]), __uint_as_float(rr[1])); }
    constexpr float C2 = 1.4426950408889634f * SCALE;
    if (__builtin_expect(__all((pmax - m_reg) * SCALE <= THR), 1)) { mn = m_reg; alpha = 1.f; }
    else { mn = fmaxf(m_reg, pmax); alpha = __builtin_amdgcn_exp2f((m_reg - mn) * C2); m_reg = mn; }
    const float mnL = -mn * C2;
    for (int r = 0; r < 16; ++r) p0[r] = fmaf(p0[r], C2, mnL); for (int r = 0; r < 16; ++r) p1[r] = fmaf(p1[r], C2, mnL);
    for (int r = 0; r < 16; ++r) p0[r] = __builtin_amdgcn_exp2f(p0[r]);
}
__device__ __forceinline__ void finishSM(f32x16& p0, f32x16& p1, float alpha, float& l_reg, bf16x8& pa0, bf16x8& pa1, bf16x8& pa2, bf16x8& pa3) {
    for (int r = 0; r < 16; ++r) p1[r] = __builtin_amdgcn_exp2f(p1[r]);
    float ps = 0; for (int r = 0; r < 16; ++r) ps += p0[r]; for (int r = 0; r < 16; ++r) ps += p1[r];
    { auto rr = __builtin_amdgcn_permlane32_swap(__float_as_uint(ps), __float_as_uint(ps), false, false);
      ps = __uint_as_float(rr[0]) + __uint_as_float(rr[1]); }
    l_reg = l_reg * alpha + ps;
#define PK4(P, B_, OUT) do { unsigned a0 = cvtpk(P[B_+0], P[B_+1]), a1 = cvtpk(P[B_+2], P[B_+3]);                          \
        unsigned b0 = cvtpk(P[B_+4], P[B_+5]), b1 = cvtpk(P[B_+6], P[B_+7]);                                             \
        auto r0 = __builtin_amdgcn_permlane32_swap(a0, b0, false, false); auto r1 = __builtin_amdgcn_permlane32_swap(a1, b1, false, false); \
        u32x4 w = {r0[0], r1[0], r0[1], r1[1]}; OUT = *reinterpret_cast<bf16x8*>(&w); } while (0)
    PK4(p0, 0, pa0); PK4(p0, 8, pa1); PK4(p1, 0, pa2); PK4(p1, 8, pa3);
#undef PK4
}
template <int KB, bool SK>
__device__ __forceinline__ void qkt(f32x16& p0, f32x16& p1, const char* K_lds, int r32, int hi, const bf16x8* qr, const char* ql, bool act) {
    if (SK && !act) { const float NEG = -__builtin_inff();
#pragma unroll
        for (int r = 0; r < 16; ++r) { p0[r] = NEG; p1[r] = NEG; } return; }
    p0 = f32x16{}; p1 = f32x16{};
    const char* kb[4];
#pragma unroll
    for (int dd = 0; dd < 4; ++dd) kb[dd] = K_lds + KB * SHM_K + KSWZ(r32, (dd * 16 + hi * 8) * 2);
#pragma unroll
    for (int d0 = 0; d0 < 8; ++d0) { const char* a = kb[d0 & 3] + (d0 >> 2) * 128;
        bf16x8 b0 = *reinterpret_cast<const bf16x8*>(a);
        bf16x8 b1 = *reinterpret_cast<const bf16x8*>(a + 32 * 256);
        const bf16x8 qv = d0 < 2 ? qr[d0] : *reinterpret_cast<const bf16x8*>(ql + (d0 - 2) * 1024);
        p0 = __builtin_amdgcn_mfma_f32_32x32x16_bf16(b0, qv, p0, 0, 0, 0);
        p1 = __builtin_amdgcn_mfma_f32_32x32x16_bf16(b1, qv, p1, 0, 0, 0); }
}
template <int VB, bool SK>
__device__ __forceinline__ void pv_tile(f32x16* o, int vb0, bf16x8 pa0, bf16x8 pa1, bf16x8 pa2, bf16x8 pa3, bool act) {
    if (SK && !act) return;
#define TRRD(dst, off) asm volatile("ds_read_b64_tr_b16 %0, %1 offset:%2" : "=&v"(dst) : "v"(vb0), "i"(off) : "memory")
#define PV_D0(d0) do { s16x4 l0, l1, l2, l3, h0, h1, h2, h3; constexpr int b_ = VB * SHM_V + v_rd_off(d0, 0, 0);     \
        TRRD(l0, b_); TRRD(h0, b_ + 2048); TRRD(l1, b_ + 4096); TRRD(h1, b_ + 6144); TRRD(l2, b_ + 8192); TRRD(h2, b_ + 10240); TRRD(l3, b_ + 12288); TRRD(h3, b_ + 14336); \
        asm volatile("s_waitcnt lgkmcnt(0)" ::: "memory"); SBAR();                 \
        o[d0] = __builtin_amdgcn_mfma_f32_32x32x16_bf16(pa0, (bf16x8){l0[0], l0[1], l0[2], l0[3], h0[0], h0[1], h0[2], h0[3]}, o[d0], 0, 0, 0);   \
        o[d0] = __builtin_amdgcn_mfma_f32_32x32x16_bf16(pa1, (bf16x8){l1[0], l1[1], l1[2], l1[3], h1[0], h1[1], h1[2], h1[3]}, o[d0], 0, 0, 0);   \
        o[d0] = __builtin_amdgcn_mfma_f32_32x32x16_bf16(pa2, (bf16x8){l2[0], l2[1], l2[2], l2[3], h2[0], h2[1], h2[2], h2[3]}, o[d0], 0, 0, 0);   \
        o[d0] = __builtin_amdgcn_mfma_f32_32x32x16_bf16(pa3, (bf16x8){l3[0], l3[1], l3[2], l3[3], h3[0], h3[1], h3[2], h3[3]}, o[d0], 0, 0, 0); } while (0)
    PV_D0(0); PV_D0(1); PV_D0(2); PV_D0(3);
#undef PV_D0
#undef TRRD
}

template <class TIn, class TOut> struct BlockRef { const TIn* Q; const TIn* K; const TIn* V; TOut* O; int P0; const unsigned long long* BM; };
template <class TIn> struct Seam {
    bf16x8 qr[8];
    bf16x8 st_v0, st_v1, st_k0, st_k1; f32x4 sf0, sf1, sf2, sf3;
    f32x4 tq[16];
};
__device__ __forceinline__ int swa_jlo(int P0, int W) { const int lowk = P0 - W + 1; return lowk > 0 ? lowk / KVBLK : 0; }
#define ROW(p, k0, rr) ((p) + (size_t)((k0) + (rr)) * KVS + sc)
#define VMW() asm volatile("s_waitcnt vmcnt(0)" ::: "memory")
#define VMWN(n) asm volatile("s_waitcnt vmcnt(%0)" :: "i"(n) : "memory")
#define SLOAD_H(Kp, Vp, k0) do { S.st_v0 = load8<TIn>(ROW(Vp, k0, sr)); S.st_v1 = load8<TIn>(ROW(Vp, k0, 32 + sr));              \
                         S.st_k0 = load8<TIn>(ROW(Kp, k0, sr)); S.st_k1 = load8<TIn>(ROW(Kp, k0, 32 + sr)); } while (0)
#define SWRITE_HK(bf) do { *(bf16x8*)(K_lds + (bf) * SHM_K + kws) = S.st_k0; *(bf16x8*)(K_lds + (bf) * SHM_K + kws + 32 * 256) = S.st_k1; } while (0)
#define SWRITE_HV(bf) do { *(bf16x8*)(V_lds + (bf) * SHM_V + vst0) = S.st_v0; *(bf16x8*)(V_lds + (bf) * SHM_V + vst1) = S.st_v1; } while (0)
#define SWRITE_H(bf) do { SWRITE_HV(bf); SWRITE_HK(bf); } while (0)
#define SLOAD_F(p, k0) do { S.sf0 = *(const f32x4*)ROW(p, k0, sr); S.sf1 = *(const f32x4*)(ROW(p, k0, sr) + 4);                \
                            S.sf2 = *(const f32x4*)ROW(p, k0, 32 + sr); S.sf3 = *(const f32x4*)(ROW(p, k0, 32 + sr) + 4); } while (0)
#define SWRITE_KF(bf) do { *(bf16x8*)(K_lds + (bf) * SHM_K + kws) = pack8(S.sf0, S.sf1); *(bf16x8*)(K_lds + (bf) * SHM_K + kws + 32 * 256) = pack8(S.sf2, S.sf3); } while (0)
#define SWRITE_VF(bf) do { *(bf16x8*)(V_lds + (bf) * SHM_V + vst0) = pack8(S.sf0, S.sf1); *(bf16x8*)(V_lds + (bf) * SHM_V + vst1) = pack8(S.sf2, S.sf3); } while (0)
template <class TIn, class TOut>
__device__ __forceinline__ void causal_swa_prime(const BlockRef<TIn, TOut>& cur, int W, char* lds, Seam<TIn>& S) {
    constexpr bool F32 = same_t<TIn, float>::v;
    const int tid = threadIdx.x, wid = __builtin_amdgcn_readfirstlane(tid >> 6), lane = tid & 63, r32 = lane & 31, hi = lane >> 5;
    const int sr = tid >> 4, sc = (tid & 15) * 8, kws = KSWZ(sr, sc * 2); char* K_lds = lds + 2 * SHM_V;
    const int kb0 = swa_jlo(cur.P0, W) * KVBLK;
    for (int d0 = 0; d0 < 8; ++d0) S.qr[d0] = load8<TIn>(cur.Q + (size_t)(wid * QBLK + r32) * QS + d0 * 16 + hi * 8);
    if constexpr (F32) { SLOAD_F((const float*)cur.K, kb0); VMW(); SWRITE_KF(0); SBAR(); SLOAD_F((const float*)cur.V, kb0); }
    else { SLOAD_H(cur.K, cur.V, kb0); VMW(); SWRITE_HK(0); }
    __syncthreads();
}
template <class TIn, class TOut>
__device__ __forceinline__ void causal_swa_block(const BlockRef<TIn, TOut>& cur, const BlockRef<TIn, TOut>& nxt, int skv, int W, char* lds, Seam<TIn>& S) {
    constexpr bool F32 = same_t<TIn, float>::v;
    int tid_ = threadIdx.x; asm volatile("" : "+v"(tid_));
    const int tid = tid_, wid = __builtin_amdgcn_readfirstlane(tid >> 6), lane = tid & 63, r32 = lane & 31, hi = lane >> 5;
    const int j_lo = swa_jlo(cur.P0, W);
    int j_hi = (cur.P0 + QB - 1) / KVBLK + 1; if (j_hi > skv / KVBLK) j_hi = skv / KVBLK;
    const int NT = j_hi - j_lo;
    const int kbn = swa_jlo(nxt.P0, W) * KVBLK;
    const unsigned long long* bmrow = cur.BM + (size_t)(wid * QBLK + r32) * 65;
    char* Qw = lds + LDS_BYTES + wid * 6144 + lane * 16;
#pragma unroll
    for (int d0 = 2; d0 < 8; ++d0) *reinterpret_cast<bf16x8*>(Qw + (d0 - 2) * 1024) = S.qr[d0];
    const int qlo = cur.P0 + wid * QBLK, qm = qlo + r32 - 4 * hi;
    char* V_lds = lds; char* K_lds = lds + 2 * SHM_V;
    float* ws = (float*)(lds + 2 * SHM_V + 2 * SHM_K) + wid * 64; float* li_l = ws, * al_l = ws + 32;
    float m_reg = -1e30f, l_reg = 0; f32x16 o[4] = {};
    const int sr = tid >> 4, sc = (tid & 15) * 8, vst0 = v_st(sr, sc), vst1 = v_st(32 + sr, sc), kws = KSWZ(sr, sc * 2);
    const int vb0 = (int)(uintptr_t)V_lds + v_rd_base(lane);
    const TIn* Kh = cur.K; const TIn* Vh = cur.V;
#define RESC(a) do { if (__any((a) < 1.f)) { if (hi == 0) al_l[r32] = (a); asm volatile("s_waitcnt lgkmcnt(0)" ::: "memory");              \
                     for (int d_ = 0; d_ < 4; ++d_) for (int r = 0; r < 16; ++r) o[d_][r] *= al_l[crow(r, hi)]; } } while (0)
#define KBASE(t) ((j_lo + (t)) * KVBLK)
#define ACT(t) (KBASE(t) <= qlo + QBLK - 1 && KBASE(t) + KVBLK - 1 >= qlo - W + 1)
#define MASKT(P0_, P1_, WORD_) do { mask_bits(P0_, P1_, WORD_, hi); } while (0)
    constexpr int NQL = F32 ? 16 : 8;
    constexpr bool SK = WSKIP && !F32;
#define SEAM_K0() do { VMWN(NQL); if constexpr (F32) { SWRITE_KF(0); SBAR(); SLOAD_F((const float*)nxt.V, kbn); } else { SWRITE_HK(0); } SBAR(); } while (0)
    f32x16 pA0, pA1, pB0, pB1; float mnA, mnB, alA, alB; bf16x8 pa0, pa1, pa2, pa3;
    if constexpr (F32) { VMW(); SWRITE_VF(0); SBAR(); } else { SWRITE_HV(0); SBAR(); }
    if (NT > 1) { if constexpr (F32) SLOAD_F((const float*)Kh, KBASE(1)); else SLOAD_H(Kh, Vh, KBASE(1)); }
    unsigned long long bmA = bmrow[j_lo], bmB = bmrow[j_lo + (NT > 1 ? 1 : 0)];
    SBAR(); qkt<0, SK>(pA0, pA1, K_lds, r32, hi, S.qr, Qw, ACT(0));
    if constexpr (F32) { if (NT > 1) { VMW(); SWRITE_KF(1); SBAR(); SLOAD_F((const float*)Vh, KBASE(1)); } }
    MASKT(pA0, pA1, bmA); partialSM(pA0, pA1, m_reg, mnA, alA);
    if (NT > 1) { VMW(); if constexpr (F32) { SWRITE_VF(1); SBAR(); if (NT > 2) SLOAD_F((const float*)Kh, KBASE(2)); } else SWRITE_H(1); }
    __syncthreads();
#define HALF_STEP(PX0, PX1, mnX, alX, PY0, PY1, alY, t, KB, VB, SB, WX, WN) do {                                                      \
        SBAR(); qkt<KB, SK>(PX0, PX1, K_lds, r32, hi, S.qr, Qw, ACT(t));                                             \
        WN = bmrow[j_lo + ((t) + 1 < NT ? (t) + 1 : (t))];                                                                  \
        finishSM(PY0, PY1, alY, l_reg, pa0, pa1, pa2, pa3); SBAR();                                                           \
        if ((t) + 1 < NT) { if constexpr (F32) { VMW(); SWRITE_KF(SB); SBAR(); SLOAD_F((const float*)Vh, KBASE((t) + 1)); }  \
                            else { SLOAD_H(Kh, Vh, KBASE((t) + 1)); } SBAR(); }                                               \
        pv_tile<VB, SK>(o, vb0, pa0, pa1, pa2, pa3, ACT((t) - 1)); MASKT(PX0, PX1, WX); partialSM(PX0, PX1, m_reg, mnX, alX);                                        \
        __syncthreads();                                                                                                      \
        if ((t) + 1 < NT) { VMW(); if constexpr (F32) { SWRITE_VF(SB); SBAR(); if ((t) + 2 < NT) SLOAD_F((const float*)Kh, KBASE((t) + 2)); } \
                            else { SWRITE_H(SB); } }                                                                          \
        RESC(alX); __syncthreads(); } while (0)
    for (int t = 1; t + 1 < NT; t += 2) {
        HALF_STEP(pB0, pB1, mnB, alB, pA0, pA1, alA, t, 1, 0, 0, bmB, bmA);
        HALF_STEP(pA0, pA1, mnA, alA, pB0, pB1, alB, t + 1, 0, 1, 1, bmA, bmB);
    }
    const bool even = (NT & 1) == 0;
    if (even) { SBAR(); qkt<1, SK>(pB0, pB1, K_lds, r32, hi, S.qr, Qw, ACT(NT - 1)); SBAR(); }
#define QROW(e) (nxt.Q + (size_t)(wid * QBLK + r32) * QS + ((e) >> 1) * 16 + hi * 8 + ((e) & 1) * 4)
    if constexpr (F32) { SLOAD_F((const float*)nxt.K, kbn); SBAR();
#pragma unroll
        for (int e = 0; e < 8; ++e) S.tq[e] = *(const f32x4*)QROW(e); }
    else { SLOAD_H(nxt.K, nxt.V, kbn); SBAR();
#pragma unroll
        for (int d0 = 0; d0 < 8; ++d0) S.qr[d0] = load8<TIn>(nxt.Q + (size_t)(wid * QBLK + r32) * QS + d0 * 16 + hi * 8); }
    SBAR();
    finishSM(pA0, pA1, alA, l_reg, pa0, pa1, pa2, pa3); SBAR();
    if constexpr (F32) {
#pragma unroll
        for (int e = 8; e < 16; ++e) S.tq[e] = *(const f32x4*)QROW(e); SBAR(); }
#undef QROW
    pv_tile<0, SK>(o, vb0, pa0, pa1, pa2, pa3, ACT(even ? NT - 2 : NT - 1));
    if (even) { MASKT(pB0, pB1, bmB); partialSM(pB0, pB1, m_reg, mnB, alB); __syncthreads(); RESC(alB);
        finishSM(pB0, pB1, alB, l_reg, pa0, pa1, pa2, pa3); SBAR(); pv_tile<1, SK>(o, vb0, pa0, pa1, pa2, pa3, ACT(NT - 1)); }
    SBAR(); SEAM_K0();
    if (hi == 0) li_l[r32] = l_reg; asm volatile("s_waitcnt lgkmcnt(0)" ::: "memory");
    float rli[16];
#pragma unroll
    for (int r = 0; r < 16; ++r) rli[r] = __builtin_amdgcn_rcpf(li_l[crow(r, hi)]);
    TOut* Ow = cur.O + (size_t)(wid * QBLK) * OS;
#pragma unroll
    for (int r = 0; r < 16; ++r) { const int orow = crow(r, hi);
#pragma unroll
        for (int d0 = 0; d0 < 4; ++d0) { const float v = o[d0][r] * rli[r];
            if constexpr (same_t<TOut, float>::v) { Ow[(size_t)orow * OS + d0 * 32 + r32] = v; }
            else { const float vn = __shfl_xor(v, 1);
                   if ((r32 & 1) == 0) *(unsigned*)(Ow + (size_t)orow * OS + d0 * 32 + r32) = cvtpk(v, vn); } } }
    if constexpr (F32) {
#pragma unroll
        for (int d0 = 0; d0 < 8; ++d0) S.qr[d0] = pack8(S.tq[2 * d0], S.tq[2 * d0 + 1]); }
    __syncthreads();
#undef RESC
#undef KBASE
#undef ACT
#undef MASKT
#undef SEAM_K0
#undef HALF_STEP
}
#undef ROW
#undef VMW
#undef VMWN
#undef SLOAD_H
#undef SWRITE_HK
#undef SWRITE_HV
#undef SWRITE_H
#undef SLOAD_F
#undef SWRITE_KF
#undef SWRITE_VF

#undef KSWZ
#undef SBAR
}

typedef att::BlockRef<att::bf16, att::bf16> AttRef;
__device__ __forceinline__ AttRef att_ref(const att::bf16* AQ, const att::bf16* AKV, att::bf16* Y, const u64* BM, int G, int blk, int seq) {
    const int n = blk + G * (seq >> 1);
    const int b = n & 7, m = n >> 3, h = m >> 3, y = m & 7, qb = (seq & 1) ? 15 - y : y;
    const size_t row0 = (size_t)b * TP + ROW0 + 256 * qb;
    AttRef r; r.Q = AQ + row0 * 1024 + h * 128; r.K = AKV + ((size_t)b * TP + PADF) * 512 + (h >> 2) * 128; r.V = r.K + 256; r.O = Y + row0 * 1024 + h * 128;
    r.P0 = NMETA + 256 * qb; r.BM = BM + ((size_t)b * SEQ + 256 * qb) * 65; return r;
}
__device__ __forceinline__ void attn_dense(Frame& F, char* ldsg) {
    const att::bf16* AQ = (const att::bf16*)slot(F, 1); const att::bf16* AKV = (const att::bf16*)slot(F, 2); att::bf16* Y = (att::bf16*)slot(F, 6);
    const int blk = blockIdx.x, G = F.G;
    const int nitems = (512 - blk + G - 1) / G, nseq = 2 * (nitems > 0 ? nitems : 0);
    if (nseq <= 0) return;
    const int W = 1 << 20;
    att::Seam<att::bf16> S;
    AttRef cur = att_ref(AQ, AKV, Y, F.BM, G, blk, 0);
    att::causal_swa_prime<att::bf16, att::bf16>(cur, W, ldsg, S);
    for (int s = 0; s < nseq; ++s) {
        const AttRef nxt = att_ref(AQ, AKV, Y, F.BM, G, blk, s + 1 < nseq ? s + 1 : s);
        att::causal_swa_block<att::bf16, att::bf16>(cur, nxt, 4160, W, ldsg, S);
        cur = nxt;
    }
}

__device__ __forceinline__ void unpack16(const u32x4& a, const u32x4& c, float (&v)[16]) {
    v[0] = bf_lo(a.x); v[1] = bf_hi(a.x); v[2] = bf_lo(a.y); v[3] = bf_hi(a.y); v[4] = bf_lo(a.z); v[5] = bf_hi(a.z); v[6] = bf_lo(a.w); v[7] = bf_hi(a.w);
    v[8] = bf_lo(c.x); v[9] = bf_hi(c.x); v[10] = bf_lo(c.y); v[11] = bf_hi(c.y); v[12] = bf_lo(c.z); v[13] = bf_hi(c.z); v[14] = bf_lo(c.w); v[15] = bf_hi(c.w);
}
__device__ __forceinline__ void rowpass1(Frame& F) {
    const int lane = F.lane;
    const bf16* MIX = slot(F, 1); bf16* N2 = slot(F, 2);
    const f32x4* gp = (const f32x4*)(F.g_post_mix + 16 * lane); const f32x4* g2 = (const f32x4*)(F.g_pre_mlp + 16 * lane);
    const f32x4 gpa = gp[0], gpb = gp[1], gpc = gp[2], gpd = gp[3], ga = g2[0], gb = g2[1], gc = g2[2], gd = g2[3];
    for (int q0 = F.gw * 4; q0 < NB * SEQ; q0 += F.NGW * 4) {
        u32x4 ma[4], mc[4]; f32x4 xv[4][4];
#pragma unroll
        for (int k = 0; k < 4; ++k) { const int q = q0 + k; const size_t r = (size_t)(q >> 12) * TP + ROW0 + (q & 4095);
            ma[k] = *(const u32x4*)(MIX + r * 1024 + 16 * lane); mc[k] = *(const u32x4*)(MIX + r * 1024 + 16 * lane + 8);
            const f32x4* xp = (const f32x4*)(F.x + (size_t)q * 1024 + 16 * lane); xv[k][0] = xp[0]; xv[k][1] = xp[1]; xv[k][2] = xp[2]; xv[k][3] = xp[3]; }
#pragma unroll
        for (int k = 0; k < 4; ++k) { const int q = q0 + k; const size_t r = (size_t)(q >> 12) * TP + ROW0 + (q & 4095);
            float m[16]; unpack16(ma[k], mc[k], m);
            float ss = 0.f;
#pragma unroll
            for (int i = 0; i < 16; ++i) ss += m[i] * m[i];
            const float rs = 1.0f / sqrtf(wave_sum(ss) * (1.f / 1024.f) + EPS);
            f32x4 h0, h1, h2v, h3;
            h0.x = xv[k][0].x + m[0] * rs * gpa.x; h0.y = xv[k][0].y + m[1] * rs * gpa.y; h0.z = xv[k][0].z + m[2] * rs * gpa.z; h0.w = xv[k][0].w + m[3] * rs * gpa.w;
            h1.x = xv[k][1].x + m[4] * rs * gpb.x; h1.y = xv[k][1].y + m[5] * rs * gpb.y; h1.z = xv[k][1].z + m[6] * rs * gpb.z; h1.w = xv[k][1].w + m[7] * rs * gpb.w;
            h2v.x = xv[k][2].x + m[8] * rs * gpc.x; h2v.y = xv[k][2].y + m[9] * rs * gpc.y; h2v.z = xv[k][2].z + m[10] * rs * gpc.z; h2v.w = xv[k][2].w + m[11] * rs * gpc.w;
            h3.x = xv[k][3].x + m[12] * rs * gpd.x; h3.y = xv[k][3].y + m[13] * rs * gpd.y; h3.z = xv[k][3].z + m[14] * rs * gpd.z; h3.w = xv[k][3].w + m[15] * rs * gpd.w;
            { u32x4 e0, e1;
              e0.x = cvtpk(h0.x, h0.y); e0.y = cvtpk(h0.z, h0.w); e0.z = cvtpk(h1.x, h1.y); e0.w = cvtpk(h1.z, h1.w); e1.x = cvtpk(h2v.x, h2v.y); e1.y = cvtpk(h2v.z, h2v.w); e1.z = cvtpk(h3.x, h3.y); e1.w = cvtpk(h3.z, h3.w);
              u32x4* hp = (u32x4*)(slot(F, 1) + r * 1024 + 16 * lane); hp[0] = e0; hp[1] = e1; }
            const float s2 = (h0.x * h0.x + h0.y * h0.y + h0.z * h0.z + h0.w * h0.w) + (h1.x * h1.x + h1.y * h1.y + h1.z * h1.z + h1.w * h1.w)
                           + (h2v.x * h2v.x + h2v.y * h2v.y + h2v.z * h2v.z + h2v.w * h2v.w) + (h3.x * h3.x + h3.y * h3.y + h3.z * h3.z + h3.w * h3.w);
            const float r2 = 1.0f / sqrtf(wave_sum(s2) * (1.f / 1024.f) + EPS);
            u32x4 w0, w1;
            w0.x = cvtpk(h0.x * r2 * ga.x, h0.y * r2 * ga.y); w0.y = cvtpk(h0.z * r2 * ga.z, h0.w * r2 * ga.w); w0.z = cvtpk(h1.x * r2 * gb.x, h1.y * r2 * gb.y); w0.w = cvtpk(h1.z * r2 * gb.z, h1.w * r2 * gb.w);
            w1.x = cvtpk(h2v.x * r2 * gc.x, h2v.y * r2 * gc.y); w1.y = cvtpk(h2v.z * r2 * gc.z, h2v.w * r2 * gc.w); w1.z = cvtpk(h3.x * r2 * gd.x, h3.y * r2 * gd.y); w1.w = cvtpk(h3.z * r2 * gd.z, h3.w * r2 * gd.w);
            u32x4* d = (u32x4*)(N2 + r * 1024 + 16 * lane); d[0] = w0; d[1] = w1;
        }
    }
}
__device__ __forceinline__ void rowpass2(Frame& F) {
    const int lane = F.lane;
    const bf16* DN = slot(F, 0);
    const f32x4* gp = (const f32x4*)(F.g_post_mlp + 16 * lane);
    const f32x4 gpa = gp[0], gpb = gp[1], gpc = gp[2], gpd = gp[3];
    for (int q0 = F.gw * 4; q0 < NB * SEQ; q0 += F.NGW * 4) {
        u32x4 ma[4], mc[4]; f32x4 hv[4][4];
#pragma unroll
        for (int k = 0; k < 4; ++k) { const int q = q0 + k; const size_t r = (size_t)(q >> 12) * TP + ROW0 + (q & 4095);
            ma[k] = *(const u32x4*)(DN + r * 1024 + 16 * lane); mc[k] = *(const u32x4*)(DN + r * 1024 + 16 * lane + 8);
            const u32x4 ha = *(const u32x4*)(slot(F, 1) + r * 1024 + 16 * lane), hc2 = *(const u32x4*)(slot(F, 1) + r * 1024 + 16 * lane + 8);
            hv[k][0] = (f32x4){bf_lo(ha.x), bf_hi(ha.x), bf_lo(ha.y), bf_hi(ha.y)}; hv[k][1] = (f32x4){bf_lo(ha.z), bf_hi(ha.z), bf_lo(ha.w), bf_hi(ha.w)};
            hv[k][2] = (f32x4){bf_lo(hc2.x), bf_hi(hc2.x), bf_lo(hc2.y), bf_hi(hc2.y)}; hv[k][3] = (f32x4){bf_lo(hc2.z), bf_hi(hc2.z), bf_lo(hc2.w), bf_hi(hc2.w)}; }
#pragma unroll
        for (int k = 0; k < 4; ++k) { const int q = q0 + k;
            float m[16]; unpack16(ma[k], mc[k], m);
            float ss = 0.f;
#pragma unroll
            for (int i = 0; i < 16; ++i) ss += m[i] * m[i];
            const float rs = 1.0f / sqrtf(wave_sum(ss) * (1.f / 1024.f) + EPS);
            f32x4 h0 = hv[k][0], h1 = hv[k][1], h2v = hv[k][2], h3 = hv[k][3];
            h0.x += m[0] * rs * gpa.x; h0.y += m[1] * rs * gpa.y; h0.z += m[2] * rs * gpa.z; h0.w += m[3] * rs * gpa.w;
            h1.x += m[4] * rs * gpb.x; h1.y += m[5] * rs * gpb.y; h1.z += m[6] * rs * gpb.z; h1.w += m[7] * rs * gpb.w;
            h2v.x += m[8] * rs * gpc.x; h2v.y += m[9] * rs * gpc.y; h2v.z += m[10] * rs * gpc.z; h2v.w += m[11] * rs * gpc.w;
            h3.x += m[12] * rs * gpd.x; h3.y += m[13] * rs * gpd.y; h3.z += m[14] * rs * gpd.z; h3.w += m[15] * rs * gpd.w;
            f32x4* op = (f32x4*)(F.out + (size_t)q * 1024 + 16 * lane); op[0] = h0; op[1] = h1; op[2] = h2v; op[3] = h3;
        }
    }
}

template <class Epi>
__device__ __forceinline__ void run_gemm(Frame& F, const bf16* A, const bf16* Bt, int K, int rowmode, int nM, int nN, const Epi& E) {
    pg8::Gemm g{A, Bt, K, rowmode}; pg8::StaticOrder S; S.init(nM, nN, F.G, (int)blockIdx.x);
    pg8::gemm_phase<Epi, pg8::StaticOrder, true, true>(F.lds, g, S, E);
}

__device__ __forceinline__ void fill_frame(Frame& F) {
    const __attribute__((address_space(4))) Args* kp = (const __attribute__((address_space(4))) Args*)__builtin_amdgcn_kernarg_segment_ptr();
    asm volatile("" : "+s"(kp));
    F.x = kp->in[0]; F.meta = kp->in[1]; F.g_pre_mix = kp->in[2]; F.w_in = kp->in[3]; F.conv_w = kp->in[4]; F.a_log = kp->in[5]; F.dt_bias = kp->in[6]; F.gdn_norm = kp->in[7];
    F.w_bg = kp->in[8]; F.w_bd = kp->in[9]; F.w_out = kp->in[10]; F.g_post_mix = kp->in[11]; F.g_pre_mlp = kp->in[12]; F.w_up = kp->in[13]; F.w_down = kp->in[14]; F.g_post_mlp = kp->in[15];
    F.out = kp->out; F.ws = kp->ws; F.ob = (unsigned char*)kp->out;
    unsigned char* ws = kp->ws;
    F.cosA = (float*)(ws + TAB_COSA); F.sinA = (float*)(ws + TAB_SINA); F.cosI = (float*)(ws + TAB_COSI); F.sinI = (float*)(ws + TAB_SINI);
    F.BG = (float*)(ws + WS_BG); F.GL = (float*)(ws + WS_GL); F.IKB = (bf16*)(ws + WS_IKB); F.SMALL = (float*)(F.ob + DO_SMALL); F.BM = (u64*)(F.ob + DO_BM);
    F.WIN = (bf16*)(ws + WS_WIN); F.WG = (bf16*)(ws + WS_WG); F.WD = (bf16*)(ws + WS_WD); F.WO = (bf16*)(ws + WS_WO); F.WUP = (bf16*)(ws + WS_WUP); F.WDN = (bf16*)(ws + WS_WDN);
}

__global__ void __launch_bounds__(NWAVES * 64, 2) fwd_kernel(Args args) {
    extern __shared__ __attribute__((aligned(16))) unsigned char lds[];
    Frame F;
    F.lds = (LAS unsigned char*)lds;
    F.tid = threadIdx.x; F.lane = F.tid & 63; F.wave = __builtin_amdgcn_readfirstlane(F.tid >> 6);
    F.G = gridDim.x; F.gw = blockIdx.x * NWAVES + F.wave; F.NGW = F.G * NWAVES;
    volatile LAS unsigned* MISC = (volatile LAS unsigned*)(F.lds + MISC_OFF);
    if (F.tid < 16) MISC[F.tid] = 0u;
    __syncthreads();
    XcdBarrier bar = xcd_barrier_post((unsigned*)(args.ws + WS_CTL) + CW_BAR, MISC + 8);
    const int lo = args.ph_lo, hi = args.ph_hi;
#ifdef ONLY_PHASE
#define IN(k) ((k) == ONLY_PHASE)
#else
#define IN(k) (lo <= (k) && (k) < hi)
#endif
#ifndef REPEAT_MASK
#define REPEAT_MASK 0
#endif
#define NREP(k) (((REPEAT_MASK >> (k)) & 1) ? 2 : 1)
#define SEAM(k) do { if (IN((k) + 1)) xcd_barrier(bar); } while (0)
#define PH_BEGIN(k) _Pragma("nounroll") for (int rep_ = 0; rep_ < NREP(k); ++rep_) { fill_frame(F)
#define PH_END(k) } SEAM(k)

    if (IN(0)) { PH_BEGIN(0); p0_prologue(F); PH_END(0); }
    if (IN(1)) { PH_BEGIN(1); pg8::EpiG E{slot(F, 1), F.SMALL, F.cosI, F.sinI}; run_gemm(F, slot(F, 0), F.WIN, 1024, 0, 130, 17, E); PH_END(1); }
    if (IN(2)) { PH_BEGIN(2); g1_phase(F); PH_END(2); }
    if (IN(3)) { PH_BEGIN(3); g2_phase(F, rep_ + 1 < NREP(3)); PH_END(3); }
#ifndef G3_PROBE
#define G3_PROBE 0
#endif
    if (IN(4)) { PH_BEGIN(4); if (G3_PROBE) { g3_scan<G3_PROBE>(F); __syncthreads(); } g3_scan<0>(F); PH_END(4); }
    if (IN(5)) { PH_BEGIN(5); ygdn_phase(F); } }
    if (IN(6)) { PH_BEGIN(6); pg8::EpiA E{slot(F, 1), slot(F, 2), slot(F, 2) + (size_t)M_ALL * 512, slot(F, 3), slot(F, 5), F.cosA, F.sinA, F.cosI, F.sinI};
        run_gemm(F, slot(F, 0), F.WIN + (size_t)4352 * 1024, 1024, 0, 130, 16, E); PH_END(6); }
#ifndef IDX_PROBE
#define IDX_PROBE 0
#endif
    if (IN(7)) { PH_BEGIN(7); if (IDX_PROBE) { idx_phase<IDX_PROBE>(F); __syncthreads(); } idx_phase<0>(F); PH_END(7); }
    if (IN(8)) { PH_BEGIN(8); attn_dense(F, (char*)lds); PH_END(8); }
    if (IN(9)) { PH_BEGIN(9);
        { pg8::EpiOne<pg8::EM_MUL> E{slot(F, 4), 1024, pg8::EpiAux{nullptr, nullptr, slot(F, 3), nullptr}, 1}; run_gemm(F, (const bf16*)(F.ob + DO_D0), F.WG, 1024, 1, 128, 4, E); }
        __syncthreads();
        { pg8::EpiOne<pg8::EM_MULADD> E{slot(F, 0), 1024, pg8::EpiAux{nullptr, nullptr, slot(F, 5), slot(F, 4)}, 1}; run_gemm(F, slot(F, 6), F.WD, 1024, 1, 128, 4, E); }
        PH_END(9); }
    if (IN(10)) { PH_BEGIN(10); pg8::EpiOne<pg8::EM_PLAIN> E{slot(F, 1), 1024, pg8::EpiAux{nullptr, nullptr, nullptr, nullptr}, 1}; run_gemm(F, slot(F, 0), F.WO, 1024, 1, 128, 4, E); PH_END(10); }
    if (IN(11)) { PH_BEGIN(11); rowpass1(F); PH_END(11); }
    if (IN(12)) { PH_BEGIN(12); pg8::EpiOne<pg8::EM_RELU2> E{slot(F, 3), 4096, pg8::EpiAux{nullptr, nullptr, nullptr, nullptr}, 1}; run_gemm(F, slot(F, 2), F.WUP, 1024, 1, 128, 16, E); PH_END(12); }
    if (IN(13)) { PH_BEGIN(13); pg8::EpiOne<pg8::EM_PLAIN> E{slot(F, 0), 1024, pg8::EpiAux{nullptr, nullptr, nullptr, nullptr}, 1}; run_gemm(F, slot(F, 3), F.WDN, 4096, 1, 128, 4, E); PH_END(13); }
    if (IN(14)) { fill_frame(F); rowpass2(F); }
#undef IN
#undef PH_BEGIN
#undef PH_END
#undef SEAM
}

extern "C" void kernel_launch(void* const* d_in, const int* in_sizes, int n_in, void* d_out, int out_size, void* d_ws, size_t ws_size, hipStream_t stream) {
    static int grid = 0;
    if (grid == 0) {
        if (n_in != 16 || out_size != NB * SEQ * DM || ws_size < WS_END) { fprintf(stderr, "kernel_launch: unexpected sizes (n_in %d out %d ws %zu, need %zu)\n", n_in, out_size, ws_size, (size_t)WS_END); grid = -1; return; }
        int dev = 0, cus = 0, per_cu = 0;
        if (hipGetDevice(&dev) != hipSuccess || hipDeviceGetAttribute(&cus, hipDeviceAttributeMultiprocessorCount, dev) != hipSuccess) { grid = -1; return; }
        if (hipFuncSetAttribute((const void*)fwd_kernel, hipFuncAttributeMaxDynamicSharedMemorySize, LDS_BYTES) != hipSuccess) { fprintf(stderr, "kernel_launch: hipFuncSetAttribute failed\n"); grid = -1; return; }
        if (hipOccupancyMaxActiveBlocksPerMultiprocessor(&per_cu, (const void*)fwd_kernel, NWAVES * 64, LDS_BYTES) != hipSuccess || per_cu < 1) { fprintf(stderr, "kernel_launch: occupancy query says %d\n", per_cu); per_cu = 1; }
        (void)hipGetLastError();
        grid = cus;
    }
    if (grid < 0) return;
    if (hipMemsetAsync((char*)d_ws + WS_CTL, 0, CTL_ZERO_BYTES, stream) != hipSuccess) { fprintf(stderr, "kernel_launch: hipMemsetAsync failed\n"); return; }
    Args a{};
    for (int i = 0; i < 16; ++i) a.in[i] = (const float*)d_in[i];
    a.out = (float*)d_out; a.ws = (unsigned char*)d_ws; a.ph_lo = 0; a.ph_hi = N_PHASES;
    void* kargs[] = {(void*)&a};
    const hipError_t e = hipLaunchCooperativeKernel((const void*)fwd_kernel, dim3(grid), dim3(NWAVES * 64), kargs, LDS_BYTES, stream);
    if (e != hipSuccess) fprintf(stderr, "kernel_launch: cooperative launch failed: %s (grid %d)\n", hipGetErrorString(e), grid);
}
```

```cpp
#include <hip/hip_runtime.h>
#include <hip/hip_cooperative_groups.h>
#include <hip/hip_bf16.h>
#include <cstdio>
#include <cstdint>
namespace cg = cooperative_groups;

constexpr int NB = 8, SEQ = 4096, DM = 1024, NMETA = 16, TT = 4112;
constexpr int TP = 4160, PADF = 48, ROW0 = 64;
constexpr int M_ALL = NB * TP;
constexpr int NIN = 8280;
constexpr float EPS = 1e-6f;
constexpr size_t MiB = 1u << 20;
constexpr size_t SLOT = 65 * MiB;
constexpr size_t SLOT_ELEMS = (size_t)M_ALL * 1024;
static_assert(SLOT == SLOT_ELEMS * 2, "slot size");


namespace pg8 {
#define PG8_LAS __attribute__((address_space(3)))
typedef unsigned short bf16_t;
typedef short bf16x8 __attribute__((ext_vector_type(8)));
typedef float f32x4 __attribute__((ext_vector_type(4)));
typedef unsigned u32x4 __attribute__((ext_vector_type(4)));
constexpr int BM = 256, BK = 64, HALF = 128, HTB = HALF * BK * 2  , STAGE_BYTES = 8 * HTB, NXCD = 8, WGM = 8;

__host__ __device__ __forceinline__ int lds_byte(int r, int c) { const int st = (r >> 4) * 2 + (c >> 5), rr = r & 15, cc = c & 31, ob = rr * 64 + cc * 2; return st * 1024 + (ob ^ (((ob >> 9) & 1) << 5)); }
__host__ __device__ __forceinline__ void stage_rc(int b, int& R, int& C) { const int st = b / 1024, sb = b % 1024, swz = sb ^ (((sb >> 9) & 1) << 5); R = (st >> 1) * 16 + swz / 64; C = (st & 1) * 32 + (swz % 64) / 2; }
__host__ __device__ __forceinline__ int perm32(int rho) { const int n = rho >> 4, i = rho & 15; return 8 * (i >> 2) + 4 * n + (i & 3); }


struct Unit { int pm, pn; };
struct Gemm { const bf16_t* A; const bf16_t* Bt; int K; int rowmode; };
__host__ __device__ __forceinline__ int row_base(int pm, int mode) { return mode ? (pm >> 4) * 4160 + 64 + (pm & 15) * 256 : pm * 256; }

struct StaticOrder {
    int nM, nN, nwg, G, c;
    __host__ __device__ void init(int nM_, int nN_, int G_, int c_) { nM = nM_; nN = nN_; nwg = nM * nN; G = G_; c = c_; }
    __host__ __device__ bool next(int i, Unit& u) const {
        const long L = (long)i * G + c; if (L >= nwg) return false;
        int wgid = (int)L; { const int q = nwg / NXCD, r = nwg % NXCD, xcd = wgid % NXCD, off = wgid / NXCD; wgid = (xcd < r ? xcd * (q + 1) : r * (q + 1) + (xcd - r) * q) + off; }
        const int nig = WGM * nN, gid = wgid / nig, fm = gid * WGM, gsz = (nM - fm) < WGM ? (nM - fm) : WGM;
        u.pm = fm + ((wgid % nig) % gsz); u.pn = (wgid % nig) / gsz; return true;
    }
    __device__ __forceinline__ void a_ready(const Unit&) const {}
    __device__ __forceinline__ void done(const Unit&) const {}
};

typedef float f32x2_t __attribute__((ext_vector_type(2)));
typedef __bf16 bf16x2_t __attribute__((ext_vector_type(2)));
__device__ __forceinline__ unsigned cvtpk(float lo, float hi) { f32x2_t v = {lo, hi}; bf16x2_t b = __builtin_convertvector(v, bf16x2_t); return __builtin_bit_cast(unsigned, b); }
__device__ __forceinline__ float bf_lo(unsigned w) { return __uint_as_float(w << 16); }
__device__ __forceinline__ float bf_hi(unsigned w) { return __uint_as_float(w & 0xffff0000u); }

enum { EM_PLAIN = 0, EM_ROPE128 = 1, EM_ROPE64 = 2, EM_SIGMOID = 3, EM_RELU2 = 4, EM_MUL = 5, EM_MULADD = 6 };
struct EpiAux { const float* tc; const float* ts; const bf16_t* a1; const bf16_t* a2; };
template <int MODE>
__device__ __forceinline__ void epi_bf16(const f32x4 (&acc)[2][2][4][2], int rb, bf16_t* dst, int ldc, int col0, int lc, const EpiAux& X) {
#pragma unroll
    for (int ai = 0; ai < 2; ++ai)
#pragma unroll
        for (int m = 0; m < 4; ++m) {
            const int row = rb + ai * 128 + m * 16;
            int pos = 0;
            if (MODE == EM_ROPE128 || MODE == EM_ROPE64) { pos = row % 4160 - 48; pos = pos < 0 ? 0 : pos; }
            f32x4 a00 = acc[ai][0][m][0], a01 = acc[ai][0][m][1], a10 = acc[ai][1][m][0], a11 = acc[ai][1][m][1];
            asm volatile("" : "+v"(a00), "+v"(a01), "+v"(a10), "+v"(a11) :: "memory");
#pragma unroll
            for (int bj = 0; bj < 2; ++bj) {
                f32x4 v0 = bj ? a10 : a00, v1 = bj ? a11 : a01;
                const size_t off = (size_t)row * ldc + col0 + bj * 128;
                if (MODE == EM_ROPE128 || MODE == EM_ROPE64) {
                    const int i0 = (MODE == EM_ROPE128) ? (lc >> 1) : ((lc & 63) >> 1);
                    const int tw = (MODE == EM_ROPE128) ? 64 : 32;
                    const f32x4 c = *(const f32x4*)(X.tc + pos * tw + i0), s = *(const f32x4*)(X.ts + pos * tw + i0);
                    f32x4 r0, r1;
                    r0[0] = v0[0] * c[0] - v0[1] * s[0]; r0[1] = v0[1] * c[0] + v0[0] * s[0];
                    r0[2] = v0[2] * c[1] - v0[3] * s[1]; r0[3] = v0[3] * c[1] + v0[2] * s[1];
                    r1[0] = v1[0] * c[2] - v1[1] * s[2]; r1[1] = v1[1] * c[2] + v1[0] * s[2];
                    r1[2] = v1[2] * c[3] - v1[3] * s[3]; r1[3] = v1[3] * c[3] + v1[2] * s[3];
                    v0 = r0; v1 = r1;
                }
                if (MODE == EM_SIGMOID) {
#pragma unroll
                    for (int e = 0; e < 4; ++e) { v0[e] = __builtin_amdgcn_rcpf(1.0f + __expf(-v0[e])); v1[e] = __builtin_amdgcn_rcpf(1.0f + __expf(-v1[e])); }
                }
                if (MODE == EM_RELU2) {
#pragma unroll
                    for (int e = 0; e < 4; ++e) { const float a = fmaxf(v0[e], 0.f), b = fmaxf(v1[e], 0.f); v0[e] = a * a; v1[e] = b * b; }
                }
                if (MODE == EM_MUL || MODE == EM_MULADD) {
                    const u32x4 gw = *(const u32x4*)(X.a1 + off);
                    v0[0] *= bf_lo(gw.x); v0[1] *= bf_hi(gw.x); v0[2] *= bf_lo(gw.y); v0[3] *= bf_hi(gw.y);
                    v1[0] *= bf_lo(gw.z); v1[1] *= bf_hi(gw.z); v1[2] *= bf_lo(gw.w); v1[3] *= bf_hi(gw.w);
                    if (MODE == EM_MULADD) {
                        const u32x4 tw1 = *(const u32x4*)(X.a2 + off);
                        v0[0] += bf_lo(tw1.x); v0[1] += bf_hi(tw1.x); v0[2] += bf_lo(tw1.y); v0[3] += bf_hi(tw1.y);
                        v1[0] += bf_lo(tw1.z); v1[1] += bf_hi(tw1.z); v1[2] += bf_lo(tw1.w); v1[3] += bf_hi(tw1.w);
                    }
                }
                u32x4 w; w.x = cvtpk(v0[0], v0[1]); w.y = cvtpk(v0[2], v0[3]); w.z = cvtpk(v1[0], v1[1]); w.w = cvtpk(v1[2], v1[3]);
                *(u32x4*)(dst + off) = w;
            }
        }
}

struct EpiG {
    static constexpr bool PERM = true, AFTER_DRAIN = false;
    bf16_t* raw; float* small; const float* cosI; const float* sinI;
    __device__ __forceinline__ void operator()(const f32x4 (&acc)[2][2][4][2], const Unit& u, int wr, int wc, int fr, int fq) const {
        const int rb = row_base(u.pm, 0) + wr * 64 + fr, lc = wc * 32 + 8 * fq;
        if (u.pn < 16) { const EpiAux X{nullptr, nullptr, nullptr, nullptr}; epi_bf16<EM_PLAIN>(acc, rb, raw + (size_t)(u.pn >> 2) * ((size_t)33280 * 1024), 1024, (u.pn & 3) * 256 + lc, lc, X); }
        else {
#pragma unroll
            for (int ai = 0; ai < 2; ++ai)
#pragma unroll
                for (int m = 0; m < 4; ++m) {
                    const int row = rb + ai * 128 + m * 16;
                    f32x4 v0 = acc[ai][0][m][0], v1 = acc[ai][0][m][1];
                    if (wc < 2) {
                        int pos = row % 4160 - 48; pos = pos < 0 ? 0 : pos;
                        const int i0 = lc >> 1;
                        const f32x4 c = *(const f32x4*)(cosI + pos * 32 + i0), s = *(const f32x4*)(sinI + pos * 32 + i0);
                        f32x4 r0, r1;
                        r0[0] = v0[0] * c[0] - v0[1] * s[0]; r0[1] = v0[1] * c[0] + v0[0] * s[0];
                        r0[2] = v0[2] * c[1] - v0[3] * s[1]; r0[3] = v0[3] * c[1] + v0[2] * s[1];
                        r1[0] = v1[0] * c[2] - v1[1] * s[2]; r1[1] = v1[1] * c[2] + v1[0] * s[2];
                        r1[2] = v1[2] * c[3] - v1[3] * s[3]; r1[3] = v1[3] * c[3] + v1[2] * s[3];
                        v0 = r0; v1 = r1;
                    }
                    float* o = small + (size_t)row * 128 + lc;
                    *(f32x4*)o = v0; *(f32x4*)(o + 4) = v1;
                }
        }
    }
};
struct EpiA {
    static constexpr bool PERM = true, AFTER_DRAIN = false;
    bf16_t *aq, *akv, *iq, *ga, *gb; const float *cosA, *sinA, *cosI, *sinI;
    __device__ __forceinline__ void operator()(const f32x4 (&acc)[2][2][4][2], const Unit& u, int wr, int wc, int fr, int fq) const {
        const int rb = row_base(u.pm, 1) + wr * 64 + fr, lc = wc * 32 + 8 * fq, pn = u.pn;
        const EpiAux XA{cosA, sinA, nullptr, nullptr}, XI{cosI, sinI, nullptr, nullptr};
        if (pn < 4) epi_bf16<EM_ROPE128>(acc, rb, aq, 1024, pn * 256 + lc, lc, XA);
        else if (pn == 4) epi_bf16<EM_ROPE128>(acc, rb, akv, 512, lc, lc, XA);
        else if (pn == 5) epi_bf16<EM_PLAIN>(acc, rb, akv, 512, 256 + lc, lc, XA);
        else if (pn < 8) epi_bf16<EM_ROPE64>(acc, rb, iq, 512, (pn - 6) * 256 + lc, lc, XI);
        else if (pn < 12) epi_bf16<EM_SIGMOID>(acc, rb, ga, 1024, (pn - 8) * 256 + lc, lc, XA);
        else epi_bf16<EM_SIGMOID>(acc, rb, gb, 1024, (pn - 12) * 256 + lc, lc, XA);
    }
};
template <int MODE> struct EpiOne {
    static constexpr bool PERM = true, AFTER_DRAIN = false;
    bf16_t* dst; int ldc; EpiAux X; int rowmode;
    __device__ __forceinline__ void operator()(const f32x4 (&acc)[2][2][4][2], const Unit& u, int wr, int wc, int fr, int fq) const {
        const int rb = row_base(u.pm, rowmode) + wr * 64 + fr, lc = wc * 32 + 8 * fq;
        epi_bf16<MODE>(acc, rb, dst, ldc, u.pn * 256 + lc, lc, X);
    }
};


template <class Epi, class Sched, bool ALIGN_EPI = false, bool SP2 = false>
__device__ __forceinline__ void gemm_phase(PG8_LAS unsigned char* lds, const Gemm g, const Sched& S, const Epi& E) {
    const int tid = threadIdx.x, wid = __builtin_amdgcn_readfirstlane(tid >> 6), lane = tid & 63, wr = wid >> 2, wc = wid & 3, fr = lane & 15, fq = lane >> 4;
    const int K = g.K, nt = K / BK;
    unsigned voffA[2], voffB[2];
#pragma unroll
    for (int i = 0; i < 2; ++i) { int R, C; stage_rc(tid * 16 + i * 8192, R, C); const int Rb = Epi::PERM ? ((R & ~31) + perm32(R & 31)) : R;
        voffA[i] = (unsigned)(R * K + C) * 2u; voffB[i] = (unsigned)(Rb * K + C) * 2u; }
    const size_t kstep = (size_t)(BK * 2);
    const size_t hstep = (size_t)HALF * K * 2;
    const size_t tstep = 2 * hstep;
    const unsigned ldsw = (unsigned)wid * 1024u;
    const int aoff = lds_byte(wr * 64 + fr, fq * 8), boff = lds_byte(wc * 32 + fr, fq * 8);
#define PG8_SA(b, h) (((b) * 2 + (h)) * HTB)
#define PG8_SB(b, h) ((4 + (b) * 2 + (h)) * HTB)
#define PG8_STAGE(bufoff, gbase, voff) do { _Pragma("unroll") for (int _i = 0; _i < 2; ++_i) \
        __builtin_amdgcn_global_load_lds((const unsigned*)((const char*)(gbase) + (voff)[_i]), (PG8_LAS unsigned*)(lds + (bufoff) + ldsw + _i * 8192), 16, 0, 0); } while (0)
#define PG8_LDA(dst, b, h) do { _Pragma("unroll") for (int m = 0; m < 4; ++m) _Pragma("unroll") for (int k = 0; k < 2; ++k) dst[m][k] = *(const PG8_LAS bf16x8*)(lds + PG8_SA(b, h) + aoff + m * 2048 + k * 1024); } while (0)
#define PG8_LDB(dst, b, h) do { _Pragma("unroll") for (int n = 0; n < 2; ++n) _Pragma("unroll") for (int k = 0; k < 2; ++k) dst[n][k] = *(const PG8_LAS bf16x8*)(lds + PG8_SB(b, h) + boff + n * 2048 + k * 1024); } while (0)
#define PG8_MMA(ai, bj, At, Bt) do { __builtin_amdgcn_s_setprio(1); _Pragma("unroll") for (int m = 0; m < 4; ++m) _Pragma("unroll") for (int n = 0; n < 2; ++n) _Pragma("unroll") for (int k = 0; k < 2; ++k) \
        acc[ai][bj][m][n] = __builtin_amdgcn_mfma_f32_16x16x32_bf16(Bt[n][k], At[m][k], acc[ai][bj][m][n], 0, 0, 0); __builtin_amdgcn_s_setprio(0); } while (0)
#define PG8_WAIT_V(n) asm volatile("s_waitcnt vmcnt(" #n ")" ::: "memory")
#define PG8_WAIT_L(n) asm volatile("s_waitcnt lgkmcnt(" #n ")" ::: "memory")
#define PG8_BAR __builtin_amdgcn_s_barrier()
#define PG8_SCHED __builtin_amdgcn_sched_barrier(0)
    Unit cur, nxt; int ui = 0;
    if (!S.next(0, cur)) return;
    f32x4 acc[2][2][4][2];
#pragma unroll
    for (int a = 0; a < 2; ++a)
#pragma unroll
        for (int b = 0; b < 2; ++b)
#pragma unroll
            for (int m = 0; m < 4; ++m)
#pragma unroll
                for (int n = 0; n < 2; ++n) acc[a][b][m][n] = (f32x4){0.f, 0.f, 0.f, 0.f};
    bf16x8 At[4][2], B0[2][2], B1[2][2];
    const char* cA = (const char*)g.A + (size_t)row_base(cur.pm, g.rowmode) * K * 2; const char* cB = (const char*)g.Bt + (size_t)cur.pn * tstep;
    S.a_ready(cur);
    if constexpr (SP2) {
        PG8_STAGE(PG8_SB(0, 0), cB, voffB); PG8_STAGE(PG8_SB(0, 1), cB + hstep, voffB); PG8_STAGE(PG8_SA(0, 0), cA, voffA); PG8_STAGE(PG8_SA(0, 1), cA + hstep, voffA);
        if (wr == 1) PG8_BAR;
        PG8_WAIT_V(2); PG8_BAR;
        PG8_STAGE(PG8_SB(1, 0), cB + kstep, voffB); PG8_STAGE(PG8_SA(1, 0), cA + kstep, voffA); PG8_STAGE(PG8_SB(1, 1), cB + hstep + kstep, voffB);
        PG8_WAIT_V(6); PG8_BAR;
    } else {
        PG8_STAGE(PG8_SB(0, 0), cB, voffB); PG8_STAGE(PG8_SA(0, 0), cA, voffA); PG8_STAGE(PG8_SB(0, 1), cB + hstep, voffB); PG8_STAGE(PG8_SA(0, 1), cA + hstep, voffA);
        if (wr == 1) PG8_BAR;
        PG8_WAIT_V(4); PG8_BAR;
        PG8_STAGE(PG8_SB(1, 0), cB + kstep, voffB); PG8_STAGE(PG8_SA(1, 0), cA + kstep, voffA); PG8_STAGE(PG8_SB(1, 1), cB + hstep + kstep, voffB);
        PG8_WAIT_V(6); PG8_BAR;
    }
    for (;;) {
        const bool has_next = S.next(ui + 1, nxt);
        const char* nA = has_next ? (const char*)g.A + (size_t)row_base(nxt.pm, g.rowmode) * K * 2 : cA; const char* nB = has_next ? (const char*)g.Bt + (size_t)nxt.pn * tstep : cB;
        for (int t = 0; t < nt; t += 2) {
            const bool last = (t == nt - 2);
            const char* a1 = cA + (size_t)(t + 1) * kstep;
            const char* a2 = last ? nA : cA + (size_t)(t + 2) * kstep; const char* b2 = last ? nB : cB + (size_t)(t + 2) * kstep;
            const char* a3 = a2 + kstep; const char* b3 = b2 + kstep;
            if (last && has_next) S.a_ready(nxt);
            if constexpr (SP2) {
            PG8_LDB(B0, 0, 0); PG8_LDB(B1, 0, 1); PG8_SCHED; PG8_LDA(At, 0, 0); PG8_STAGE(PG8_SA(1, 1), a1 + hstep, voffA);
            PG8_WAIT_V(8); PG8_WAIT_L(0); PG8_BAR; PG8_MMA(0, 0, At, B0); PG8_MMA(0, 1, At, B1); PG8_BAR; PG8_SCHED;
            PG8_LDA(At, 0, 1); PG8_STAGE(PG8_SB(0, 0), b2, voffB); PG8_STAGE(PG8_SB(0, 1), b2 + hstep, voffB); PG8_STAGE(PG8_SA(0, 0), a2, voffA);
            PG8_WAIT_V(8); PG8_WAIT_L(0); PG8_BAR; PG8_MMA(1, 0, At, B0); PG8_MMA(1, 1, At, B1); PG8_BAR; PG8_SCHED;
            PG8_LDB(B0, 1, 0); PG8_LDB(B1, 1, 1); PG8_SCHED; PG8_LDA(At, 1, 0); PG8_STAGE(PG8_SA(0, 1), a2 + hstep, voffA);
            PG8_WAIT_V(8); PG8_WAIT_L(0); PG8_BAR; PG8_MMA(0, 0, At, B0); PG8_MMA(0, 1, At, B1); PG8_BAR; PG8_SCHED;
            PG8_LDA(At, 1, 1); PG8_STAGE(PG8_SB(1, 0), b3, voffB); PG8_STAGE(PG8_SB(1, 1), b3 + hstep, voffB); PG8_STAGE(PG8_SA(1, 0), a3, voffA);
            PG8_WAIT_V(8); PG8_WAIT_L(0); PG8_BAR; PG8_MMA(1, 0, At, B0); PG8_MMA(1, 1, At, B1); PG8_BAR; PG8_SCHED;
            } else {
            PG8_LDB(B0, 0, 0); PG8_SCHED; PG8_LDA(At, 0, 0); PG8_STAGE(PG8_SA(1, 1), a1 + hstep, voffA);
            PG8_WAIT_L(8); PG8_BAR; PG8_WAIT_L(0); PG8_MMA(0, 0, At, B0); PG8_BAR; PG8_SCHED;
            PG8_LDB(B1, 0, 1); PG8_STAGE(PG8_SB(0, 0), b2, voffB);
            PG8_BAR; PG8_WAIT_L(0); PG8_MMA(0, 1, At, B1); PG8_BAR;
            PG8_LDA(At, 0, 1); PG8_STAGE(PG8_SA(0, 0), a2, voffA);
            PG8_BAR; PG8_WAIT_L(0); PG8_MMA(1, 0, At, B0); PG8_BAR; PG8_SCHED;
            PG8_STAGE(PG8_SB(0, 1), b2 + hstep, voffB);
            PG8_WAIT_V(6); PG8_BAR; PG8_MMA(1, 1, At, B1); PG8_BAR;
            PG8_LDB(B0, 1, 0); PG8_SCHED; PG8_LDA(At, 1, 0); PG8_STAGE(PG8_SA(0, 1), a2 + hstep, voffA);
            PG8_WAIT_L(8); PG8_BAR; PG8_WAIT_L(0); PG8_MMA(0, 0, At, B0); PG8_BAR; PG8_SCHED;
            PG8_LDB(B1, 1, 1); PG8_STAGE(PG8_SB(1, 0), b3, voffB);
            PG8_BAR; PG8_WAIT_L(0); PG8_MMA(0, 1, At, B1); PG8_BAR;
            PG8_LDA(At, 1, 1); PG8_STAGE(PG8_SA(1, 0), a3, voffA);
            PG8_BAR; PG8_WAIT_L(0); PG8_MMA(1, 0, At, B0); PG8_BAR; PG8_SCHED;
            PG8_STAGE(PG8_SB(1, 1), b3 + hstep, voffB);
            PG8_WAIT_V(6); PG8_BAR; PG8_MMA(1, 1, At, B1); PG8_BAR;
            }
        }
        if constexpr (ALIGN_EPI) { if (wr == 0) PG8_BAR; }
        if constexpr (!Epi::AFTER_DRAIN) { E(acc, cur, wr, wc, fr, fq); S.done(cur); }
        if (!has_next) break;
#pragma unroll
        for (int a = 0; a < 2; ++a)
#pragma unroll
            for (int b = 0; b < 2; ++b)
#pragma unroll
                for (int m = 0; m < 4; ++m)
#pragma unroll
                    for (int n = 0; n < 2; ++n) acc[a][b][m][n] = (f32x4){0.f, 0.f, 0.f, 0.f};
        cur = nxt; cA = nA; cB = nB; ++ui;
        if constexpr (ALIGN_EPI) { if (wr == 1) PG8_BAR; }
    }
    PG8_WAIT_V(0);
    if constexpr (!ALIGN_EPI) { if (wr == 0) PG8_BAR; }
    PG8_BAR;
    if constexpr (Epi::AFTER_DRAIN) { E.fused(acc, cur, wr, wc, fr, fq, lds, wid, lane); S.done(cur); }
#undef PG8_SA
#undef PG8_SB
#undef PG8_STAGE
#undef PG8_LDA
#undef PG8_LDB
#undef PG8_MMA
#undef PG8_WAIT_V
#undef PG8_WAIT_L
#undef PG8_BAR
#undef PG8_SCHED
}
}

#define GAS __attribute__((address_space(1)))
#define LAS __attribute__((address_space(3)))
typedef unsigned short bf16;
typedef float f32x4 __attribute__((ext_vector_type(4)));
typedef float f32x16 __attribute__((ext_vector_type(16)));
typedef unsigned u32x4 __attribute__((ext_vector_type(4)));
typedef unsigned u32x2 __attribute__((ext_vector_type(2)));
typedef short bf16x8 __attribute__((ext_vector_type(8)));
typedef unsigned long long u64;
using pg8::cvtpk; using pg8::bf_lo; using pg8::bf_hi;

#define XB_TMO      128
#define XB_XCNT(j)  (256  + 64 * (j))
#define XB_XSUB(j)  (1280 + 64 * (j))
#define XB_XGEN(j)  (2304 + 64 * (j))
#define XB_TOP      3328
#define XB_TOPGEN   3392
#define XCD_BAR_WORDS 3456
#define XB_SPIN_CAP (1u << 18)

__device__ __forceinline__ unsigned xb_ld(unsigned* p)              { return __hip_atomic_load(p, __ATOMIC_RELAXED, __HIP_MEMORY_SCOPE_AGENT); }
__device__ __forceinline__ unsigned xb_add(unsigned* p, unsigned v) { return __hip_atomic_fetch_add(p, v, __ATOMIC_RELAXED, __HIP_MEMORY_SCOPE_AGENT); }
__device__ __forceinline__ unsigned xb_xcc_id() { return (unsigned)__builtin_amdgcn_s_getreg((3 << 11) | 20) & 0xFu; }
#define XB_SPIN(cond, bar) do { unsigned _sp = 0; while (cond) { __builtin_amdgcn_s_sleep(1); \
    if ((++_sp & 255u) == 0u) { if (xb_ld(&(bar)[XB_TMO])) break; if (_sp > XB_SPIN_CAP) { atomicAdd(&(bar)[XB_TMO], 1u); break; } } } } while (0)

struct XcdBarrier {
    unsigned* bar; unsigned x;
    volatile LAS unsigned* st;
};

__device__ __forceinline__ XcdBarrier xcd_barrier_post(unsigned* bar, volatile LAS unsigned* st) {
    XcdBarrier b; b.bar = bar; b.x = xb_xcc_id(); b.st = st;
    if (threadIdx.x == 0) (void)xb_add(&bar[XB_XCNT(b.x)], 1u);
    return b;
}
__device__ __forceinline__ void xcd_barrier_complete(unsigned* bar, unsigned x, unsigned& nloc, unsigned& nx) {
    const unsigned G = gridDim.x * gridDim.y * gridDim.z;
    unsigned sum, cnt, mine, sp = 0u;
    for (;;) {
        sum = 0u; cnt = 0u; mine = 0u;
#pragma unroll
        for (unsigned j = 0; j < 16; ++j) { const unsigned c = xb_ld(&bar[XB_XCNT(j)]); sum += c; cnt += (c > 0u) ? 1u : 0u; mine = (j == x) ? c : mine; }
        if (sum == G) break;
        __builtin_amdgcn_s_sleep(1);
        if ((++sp & 255u) == 0u) { if (xb_ld(&bar[XB_TMO])) break; if (sp > XB_SPIN_CAP) { atomicAdd(&bar[XB_TMO], 1u); break; } }
    }
    nloc = mine > 0u ? mine : 1u; nx = cnt > 0u ? cnt : 1u;
}

__device__ __forceinline__ void xcd_barrier(const XcdBarrier& b) {
    asm volatile("s_waitcnt vmcnt(0)" ::: "memory");
    __syncthreads();
    if (threadIdx.x == 0) {
        unsigned* bar = b.bar;
        __builtin_amdgcn_s_waitcnt(0);
        unsigned nloc = b.st[0], nx = b.st[1];
        if (nloc == 0u) { xcd_barrier_complete(bar, b.x, nloc, nx); b.st[0] = nloc; b.st[1] = nx; }
        const unsigned old = xb_add(&bar[XB_XSUB(b.x)], 1u);
        const unsigned gen = old / nloc;
        if (old + 1u == (gen + 1u) * nloc) {
            __builtin_amdgcn_fence(__ATOMIC_RELEASE, "agent");
            asm volatile("s_waitcnt vmcnt(0)" ::: "memory");
            const unsigned og = xb_add(&bar[XB_TOP], 1u);
            const unsigned tg = og / nx;
            if (og + 1u == (tg + 1u) * nx) xb_add(&bar[XB_TOPGEN], 1u);
            else XB_SPIN(xb_ld(&bar[XB_TOPGEN]) == tg, bar);
            __builtin_amdgcn_fence(__ATOMIC_ACQUIRE, "agent");
            xb_add(&bar[XB_XGEN(b.x)], 1u);
            asm volatile("s_waitcnt vmcnt(0)" ::: "memory");
        } else {
            XB_SPIN(xb_ld(&bar[XB_XGEN(b.x)]) == gen, bar);
            __builtin_amdgcn_fence(__ATOMIC_ACQUIRE, "agent");
            asm volatile("s_waitcnt vmcnt(0)" ::: "memory");
        }
    }
    __syncthreads();
}

constexpr int NWAVES = 8;
constexpr int LDS_BYTES = 147456;
constexpr int N_PHASES = 15;
constexpr int MISC_OFF = LDS_BYTES - 64;
constexpr int CW_BAR = 1024;
constexpr size_t CTL_ZERO_BYTES = 65536;

constexpr size_t WS_CTL = 0;
constexpr size_t TAB_COSA = 1 * MiB, TAB_SINA = TAB_COSA + (size_t)TT * 64 * 4, TAB_COSI = TAB_SINA + (size_t)TT * 64 * 4, TAB_SINI = TAB_COSI + (size_t)TT * 32 * 4;
constexpr size_t WS_BG = 5 * MiB;
constexpr size_t WS_GL = 7 * MiB + 512 * 1024;
constexpr size_t WS_IKB = 8 * MiB;
constexpr size_t WS_WIN = 13 * MiB;
constexpr size_t WS_WG = 30 * MiB, WS_WD = 32 * MiB, WS_WO = 34 * MiB, WS_WUP = 36 * MiB, WS_WDN = 44 * MiB;
constexpr size_t WS_S0 = 52 * MiB;
__host__ __device__ constexpr size_t WS_S(int i) { return WS_S0 + (size_t)i * SLOT; }
constexpr size_t WS_END = WS_S0 + 7 * SLOT;
static_assert(TAB_SINI + (size_t)TT * 32 * 4 <= WS_BG && WS_BG + (size_t)M_ALL * 64 <= WS_GL && WS_GL + 65536 <= WS_IKB && WS_IKB + (size_t)M_ALL * 128 <= WS_WIN && WS_WIN + (size_t)8448 * 2048 <= WS_WG, "ws map");
constexpr size_t DO_D0 = 0;
constexpr size_t DO_SMALL = 65 * MiB;
constexpr size_t DO_BM = 82 * MiB;
static_assert(DO_SMALL + (size_t)M_ALL * 512 <= DO_BM && DO_BM + (size_t)NB * 4096 * 65 * 8 <= 128 * MiB, "d_out scratch map");

struct Args { const float* in[16]; float* out; unsigned char* ws; int ph_lo, ph_hi; };

struct Frame {
    LAS unsigned char* lds;
    int tid, lane, wave, G, gw, NGW;
    const float *x, *meta, *g_pre_mix, *w_in, *conv_w, *a_log, *dt_bias, *gdn_norm, *w_bg, *w_bd, *w_out, *g_post_mix, *g_pre_mlp, *w_up, *w_down, *g_post_mlp;
    float* out; unsigned char* ws; unsigned char* ob;
    float *cosA, *sinA, *cosI, *sinI, *BG, *SMALL, *GL;
    bf16 *IKB, *WIN, *WG, *WD, *WO, *WUP, *WDN;
    u64* BM;
};
__device__ __forceinline__ bf16* slot(const Frame& F, int i) { return (bf16*)(F.ws + WS_S(i)); }

__device__ __forceinline__ float wave_sum(float v) {
#pragma unroll
    for (int o = 1; o < 64; o <<= 1) v += __shfl_xor(v, o);
    return v;
}
__device__ __forceinline__ float wave_max(float v) {
#pragma unroll
    for (int o = 1; o < 64; o <<= 1) v = fmaxf(v, __shfl_xor(v, o));
    return v;
}
#define LDS_WAIT() asm volatile("s_waitcnt lgkmcnt(0)" ::: "memory")

__device__ __forceinline__ int win_src_col(int np) {
    if (np < 4096) return np;
    if (np < 4352) { const int j = np - 4096;
        if (j < 64) return 6160 + (j >> 1) + 32 * (j & 1);
        if (j < 72) return 6224 + (j - 64);
        if (j < 80) return 4096 + (j - 72);
        if (j < 88) return 4104 + (j - 80);
        return -1; }
    const int q = np - 4352;
    if (q < 1024) { const int hh = q >> 7, j = q & 127; return 4112 + hh * 128 + (j >> 1) + 64 * (j & 1); }
    if (q < 1280) { const int r = q - 1024, hh = r >> 7, j = r & 127; return 5136 + hh * 128 + (j >> 1) + 64 * (j & 1); }
    if (q < 1536) return 5392 + (q - 1280);
    if (q < 2048) { const int r = q - 1536, hh = r >> 6, j = r & 63; return 5648 + hh * 64 + (j >> 1) + 32 * (j & 1); }
    if (q < 3072) return 6232 + (q - 2048);
    return 7256 + (q - 3072);
}
template <bool MAP>
__device__ __forceinline__ void p0_transpose_item(const float* W, int K, int N, bf16* WT, LAS float* scr, int item, int nblk, int lane) {
    const int kb = item / nblk, nb = item % nblk, k0 = 64 * kb, n0 = 32 * nb;
    const int nd = n0 + (lane & 31); const int src = MAP ? win_src_col(nd) : nd;
#pragma unroll 8
    for (int i = 0; i < 32; ++i) { const int kk = 2 * i + (lane >> 5); scr[kk * 33 + (lane & 31)] = (src >= 0) ? W[(size_t)(k0 + kk) * N + src] : 0.f; }
    LDS_WAIT(); asm volatile("" ::: "memory");
    const int c = lane & 7;
#pragma unroll
    for (int j = 0; j < 4; ++j) { const int n = (lane >> 3) + 8 * j; const LAS float* s = scr + (8 * c) * 33 + n;
        u32x4 o; o.x = cvtpk(s[0 * 33], s[1 * 33]); o.y = cvtpk(s[2 * 33], s[3 * 33]); o.z = cvtpk(s[4 * 33], s[5 * 33]); o.w = cvtpk(s[6 * 33], s[7 * 33]);
        *(u32x4*)(WT + (size_t)(n0 + n) * K + k0 + 8 * c) = o; }
    LDS_WAIT(); asm volatile("" ::: "memory");
}
__device__ __forceinline__ void rms_row_to_bf16(const float* xrow, const float* gain, bf16* orow, int lane) {
    const f32x4* xr = (const f32x4*)xrow + lane; const f32x4* gr = (const f32x4*)gain + lane;
    f32x4 v[4]; float s = 0.f;
#pragma unroll
    for (int j = 0; j < 4; ++j) { v[j] = xr[64 * j]; s += (v[j].x * v[j].x + v[j].y * v[j].y) + (v[j].z * v[j].z + v[j].w * v[j].w); }
    const float rstd = 1.0f / sqrtf(wave_sum(s) * (1.f / 1024.f) + EPS);
    u32x2* o8 = (u32x2*)orow + lane;
#pragma unroll
    for (int j = 0; j < 4; ++j) { const f32x4 g = gr[64 * j]; u32x2 w; w.x = cvtpk(v[j].x * rstd * g.x, v[j].y * rstd * g.y); w.y = cvtpk(v[j].z * rstd * g.z, v[j].w * rstd * g.w); o8[64 * j] = w; }
}
__device__ __forceinline__ void sincos_d(double x, float& sn, float& cs) {
    const double TWO_PI = 6.283185307179586476925286766559, INV_TWO_PI = 0.15915494309189533576888376337251;
    const double n = __builtin_rint(x * INV_TWO_PI); const double r = x - n * TWO_PI; const double r2 = r * r;
    double ts = 0.0, tc = 0.0, term = 1.0, tsin = 1.0;
#pragma unroll
    for (int k = 0; k < 14; ++k) {
        tc += term; ts += tsin;
        term = -term * r2 / (double)((2 * k + 1) * (2 * k + 2));
        tsin = -tsin * r2 / (double)((2 * k + 2) * (2 * k + 3));
    }
    sn = (float)(r * ts); cs = (float)tc;
}
__device__ __forceinline__ double powi_d(double b, int e) { double r = 1.0; for (int i = 0; i < e; ++i) r *= b; return r; }

__device__ __forceinline__ void p0_prologue(Frame& F) {
    LAS float* scr = (LAS float*)(F.lds + F.wave * 16384);
    const int gw = F.gw, NGW = F.NGW, lane = F.lane;
    constexpr int I_IN = (1024 / 64) * (8448 / 32), I_SQ = (1024 / 64) * (1024 / 32), I_UP = (1024 / 64) * (4096 / 32), I_DN = (4096 / 64) * (1024 / 32);
    constexpr int NITEMS = I_IN + 3 * I_SQ + I_UP + I_DN;
    for (int it = gw; it < NITEMS; it += NGW) {
        int r = it;
        if (r < I_IN) { p0_transpose_item<true>(F.w_in, 1024, NIN, F.WIN, scr, r, 8448 / 32, lane); continue; } r -= I_IN;
        if (r < I_SQ) { p0_transpose_item<false>(F.w_bg, 1024, 1024, F.WG, scr, r, 32, lane); continue; } r -= I_SQ;
        if (r < I_SQ) { p0_transpose_item<false>(F.w_bd, 1024, 1024, F.WD, scr, r, 32, lane); continue; } r -= I_SQ;
        if (r < I_SQ) { p0_transpose_item<false>(F.w_out, 1024, 1024, F.WO, scr, r, 32, lane); continue; } r -= I_SQ;
        if (r < I_UP) { p0_transpose_item<false>(F.w_up, 1024, 4096, F.WUP, scr, r, 128, lane); continue; } r -= I_UP;
        p0_transpose_item<false>(F.w_down, 4096, 1024, F.WDN, scr, r, 32, lane);
    }
    bf16* N = slot(F, 0);
    {   const f32x4* gr = (const f32x4*)F.g_pre_mix + lane;
        const f32x4 g0 = gr[0], g1 = gr[64], g2 = gr[128], g3 = gr[192];
        for (int r0 = gw * 4; r0 < M_ALL; r0 += NGW * 4) {
            f32x4 v[4][4];
#pragma unroll
            for (int k = 0; k < 4; ++k) { const int r = r0 + k, b = r / TP, tt = r % TP - PADF;
                const float* src = (tt < NMETA) ? F.meta + (size_t)(tt < 0 ? 0 : tt) * 1024 : F.x + ((size_t)b * SEQ + (tt - NMETA)) * 1024;
                const f32x4* xr = (const f32x4*)src + lane; v[k][0] = xr[0]; v[k][1] = xr[64]; v[k][2] = xr[128]; v[k][3] = xr[192]; }
#pragma unroll
            for (int k = 0; k < 4; ++k) { const int r = r0 + k, tt = r % TP - PADF;
                float s = 0.f;
#pragma unroll
                for (int j = 0; j < 4; ++j) s += (v[k][j].x * v[k][j].x + v[k][j].y * v[k][j].y) + (v[k][j].z * v[k][j].z + v[k][j].w * v[k][j].w);
                float rstd = 1.0f / sqrtf(wave_sum(s) * (1.f / 1024.f) + EPS);
                if (tt < 0) rstd = 0.f;
                u32x2* o8 = (u32x2*)(N + (size_t)r * 1024) + lane;
                u32x2 w0, w1, w2, w3;
                w0.x = cvtpk(v[k][0].x * rstd * g0.x, v[k][0].y * rstd * g0.y); w0.y = cvtpk(v[k][0].z * rstd * g0.z, v[k][0].w * rstd * g0.w);
                w1.x = cvtpk(v[k][1].x * rstd * g1.x, v[k][1].y * rstd * g1.y); w1.y = cvtpk(v[k][1].z * rstd * g1.z, v[k][1].w * rstd * g1.w);
                w2.x = cvtpk(v[k][2].x * rstd * g2.x, v[k][2].y * rstd * g2.y); w2.y = cvtpk(v[k][2].z * rstd * g2.z, v[k][2].w * rstd * g2.w);
                w3.x = cvtpk(v[k][3].x * rstd * g3.x, v[k][3].y * rstd * g3.y); w3.y = cvtpk(v[k][3].z * rstd * g3.z, v[k][3].w * rstd * g3.w);
                o8[0] = w0; o8[64] = w1; o8[128] = w2; o8[192] = w3;
            }
        }
    }
    const int gt = blockIdx.x * 512 + F.tid, NGT = F.G * 512;
    const double BASE_A = 0.86596432336006535, BASE_I = 0.74989420933245583;
    for (int e = gt; e < TT * 64; e += NGT) { const int pos = e >> 6, i = e & 63; const float inv = (float)powi_d(BASE_A, i); const float ang = (float)pos * inv; float sn, cs; sincos_d((double)ang, sn, cs); F.cosA[e] = cs; F.sinA[e] = sn; }
    for (int e = gt; e < TT * 32; e += NGT) { const int pos = e >> 5, i = e & 31; const float inv = (float)powi_d(BASE_I, i); const float ang = (float)pos * inv; float sn, cs; sincos_d((double)ang, sn, cs); F.cosI[e] = cs; F.sinI[e] = sn; }
}

__device__ __forceinline__ float silu_f(float y) { return y / (1.0f + __expf(-y)); }
__device__ __forceinline__ void g1_unpack16(const u32x4& a, const u32x4& c, float (&v)[16]) {
    v[0] = bf_lo(a.x); v[1] = bf_hi(a.x); v[2] = bf_lo(a.y); v[3] = bf_hi(a.y); v[4] = bf_lo(a.z); v[5] = bf_hi(a.z); v[6] = bf_lo(a.w); v[7] = bf_hi(a.w);
    v[8] = bf_lo(c.x); v[9] = bf_hi(c.x); v[10] = bf_lo(c.y); v[11] = bf_hi(c.y); v[12] = bf_lo(c.z); v[13] = bf_hi(c.z); v[14] = bf_lo(c.w); v[15] = bf_hi(c.w);
}
__device__ __forceinline__ void g1_phase(Frame& F) {
    constexpr int RB = 52, NBLK = M_ALL / RB;
    static_assert(NBLK * RB == M_ALL && TP % RB == 0, "row blocks");
    for (int u = F.gw; u < 3 * NBLK; u += F.NGW) {
        int lane = F.lane; asm volatile("" : "+v"(lane));
        const int X = u / NBLK, blk = u % NBLK, row0 = blk * RB;
        const bf16* src = slot(F, 1) + (size_t)X * SLOT_ELEMS + 16 * lane;
        bf16* dst = ((X == 0) ? slot(F, 5) : (X == 1) ? slot(F, 6) : (bf16*)(F.ob + DO_D0)) + 16 * lane;
        float w0[16], w1[16], w2[16], w3[16];
        {   const float* cw = F.conv_w + X * 1024 + 16 * lane;
#pragma unroll
            for (int i = 0; i < 16; i += 4) { const f32x4 a = *(const f32x4*)(cw + i), bq = *(const f32x4*)(cw + 3072 + i), cq = *(const f32x4*)(cw + 6144 + i), dq = *(const f32x4*)(cw + 9216 + i);
                w0[i] = a.x; w0[i + 1] = a.y; w0[i + 2] = a.z; w0[i + 3] = a.w; w1[i] = bq.x; w1[i + 1] = bq.y; w1[i + 2] = bq.z; w1[i + 3] = bq.w;
                w2[i] = cq.x; w2[i + 1] = cq.y; w2[i + 2] = cq.z; w2[i + 3] = cq.w; w3[i] = dq.x; w3[i + 1] = dq.y; w3[i + 2] = dq.z; w3[i + 3] = dq.w; } }
        float xm3[16], xm2[16], xm1[16];
        {   const int r = row0;
            const int h3 = r >= 3 ? r - 3 : 0, h2 = r >= 2 ? r - 2 : 0, h1 = r >= 1 ? r - 1 : 0;
            const u32x4 a3 = *(const u32x4*)(src + (size_t)h3 * 1024), c3 = *(const u32x4*)(src + (size_t)h3 * 1024 + 8);
            const u32x4 a2 = *(const u32x4*)(src + (size_t)h2 * 1024), c2 = *(const u32x4*)(src + (size_t)h2 * 1024 + 8);
            const u32x4 a1 = *(const u32x4*)(src + (size_t)h1 * 1024), c1 = *(const u32x4*)(src + (size_t)h1 * 1024 + 8);
            g1_unpack16(a3, c3, xm3); g1_unpack16(a2, c2, xm2); g1_unpack16(a1, c1, xm1); }
        u32x4 pa[4], pc[4];
#pragma unroll
        for (int k = 0; k < 4; ++k) { pa[k] = *(const u32x4*)(src + (size_t)(row0 + k) * 1024); pc[k] = *(const u32x4*)(src + (size_t)(row0 + k) * 1024 + 8); }
        for (int rr = 0; rr < RB; rr += 4) {
#pragma unroll
            for (int k = 0; k < 4; ++k) {
                const int r = row0 + rr + k;
                float x0[16]; g1_unpack16(pa[k], pc[k], x0);
                { const int rn = (rr + 4 + k < RB) ? r + 4 : r;
                  pa[k] = *(const u32x4*)(src + (size_t)rn * 1024); pc[k] = *(const u32x4*)(src + (size_t)rn * 1024 + 8); }
                float y[16]; float ss = 0.f;
#pragma unroll
                for (int i = 0; i < 16; ++i) { const float t = w0[i] * xm3[i] + w1[i] * xm2[i] + w2[i] * xm1[i] + w3[i] * x0[i]; y[i] = t * __builtin_amdgcn_rcpf(1.0f + __expf(-t)); ss += y[i] * y[i]; }
#pragma unroll
                for (int i = 0; i < 16; ++i) { xm3[i] = xm2[i]; xm2[i] = xm1[i]; xm1[i] = x0[i]; }
                float sc = 1.f;
                if (X < 2) { ss += __shfl_xor(ss, 1); ss += __shfl_xor(ss, 2); ss += __shfl_xor(ss, 4); sc = 1.0f / sqrtf(ss + EPS); if (X == 0) sc *= 0.08838834764831845f; }
                const int tt = r % TP - PADF;
                if (tt < 0) sc = 0.f;
                u32x4 o0, o1;
                o0.x = cvtpk(y[0] * sc, y[1] * sc); o0.y = cvtpk(y[2] * sc, y[3] * sc); o0.z = cvtpk(y[4] * sc, y[5] * sc); o0.w = cvtpk(y[6] * sc, y[7] * sc);
                o1.x = cvtpk(y[8] * sc, y[9] * sc); o1.y = cvtpk(y[10] * sc, y[11] * sc); o1.z = cvtpk(y[12] * sc, y[13] * sc); o1.w = cvtpk(y[14] * sc, y[15] * sc);
                u32x4* d = (u32x4*)(dst + (size_t)r * 1024); d[0] = o0; d[1] = o1;
            }
        }
    }
    for (int idx = blockIdx.x * 512 + F.tid; idx < M_ALL * 8; idx += F.G * 512) {
        const int r = idx >> 3, hh = idx & 7, tt = r % TP - PADF;
        if (tt < 0) { F.BG[(size_t)r * 16 + hh] = 0.f; F.BG[(size_t)r * 16 + 8 + hh] = 0.f; continue; }
        const float* sm = F.SMALL + (size_t)r * 128;
        const float gb = sm[72 + hh], ga = sm[80 + hh];
        const f32x4 k0 = *(const f32x4*)(sm + 8 * hh), k1 = *(const f32x4*)(sm + 8 * hh + 4);
        const float beta = __builtin_amdgcn_rcpf(1.0f + __expf(-gb));
        const float xx = ga + F.dt_bias[hh];
        const float sp = fmaxf(xx, 0.f) + log1pf(__expf(-fabsf(xx)));
        F.BG[(size_t)r * 16 + hh] = beta; F.BG[(size_t)r * 16 + 8 + hh] = -__expf(F.a_log[hh]) * sp;
        u32x4 o; o.x = cvtpk(k0.x, k0.y); o.y = cvtpk(k0.z, k0.w); o.z = cvtpk(k1.x, k1.y); o.w = cvtpk(k1.z, k1.w);
        *(u32x4*)(F.IKB + ((((size_t)(r / TP) * 130 + (tt >> 5)) * 4 + (hh >> 1)) * 2 + (hh & 1)) * 256 + (tt & 31) * 8) = o;
    }
}

__device__ __forceinline__ void gdn_scan_naive(Frame& F) {
    if (blockIdx.x >= 64) return;
    const int b = blockIdx.x >> 3, h = blockIdx.x & 7, tid = F.tid;
    const int dv = tid >> 2, qd = tid & 3;
    LAS float* buf = (LAS float*)F.lds;
    constexpr int TS = 392, BS = 16 * TS;
    const bf16* QN = slot(F, 5); const bf16* KN = slot(F, 6); const bf16* VS = (const bf16*)(F.ob + DO_D0);
    float* OR = (float*)slot(F, 1);
    const size_t rowbase = (size_t)b * TP + PADF;
    float S[32];
#pragma unroll
    for (int i = 0; i < 32; ++i) S[i] = 0.f;
    const int tl = tid >> 5, seg = tid & 31;
    constexpr int NCH = TT / 16;
    u32x2 rk, rq, rv; float rb_ = 0.f, rg_ = 0.f;
    {   const size_t ro = (rowbase + tl) * 1024 + h * 128 + seg * 4;
        rk = *(const u32x2*)(KN + ro); rq = *(const u32x2*)(QN + ro); rv = *(const u32x2*)(VS + ro);
        if (seg == 0) { rb_ = F.BG[(rowbase + tl) * 16 + h]; rg_ = F.BG[(rowbase + tl) * 16 + 8 + h]; }
        LAS float* d = buf + tl * TS;
        *(LAS f32x4*)(d + seg * 4) = (f32x4){bf_lo(rk.x), bf_hi(rk.x), bf_lo(rk.y), bf_hi(rk.y)};
        *(LAS f32x4*)(d + 128 + seg * 4) = (f32x4){bf_lo(rq.x), bf_hi(rq.x), bf_lo(rq.y), bf_hi(rq.y)};
        *(LAS f32x4*)(d + 256 + seg * 4) = (f32x4){bf_lo(rv.x), bf_hi(rv.x), bf_lo(rv.y), bf_hi(rv.y)};
        if (seg == 0) { d[384] = rb_; d[385] = __expf(rg_); } }
    __syncthreads();
    for (int c = 0; c < NCH; ++c) {
        const bool more = (c + 1 < NCH);
        if (more) { const size_t row = rowbase + (size_t)(c + 1) * 16 + tl; const size_t ro = row * 1024 + h * 128 + seg * 4;
            rk = *(const u32x2*)(KN + ro); rq = *(const u32x2*)(QN + ro); rv = *(const u32x2*)(VS + ro);
            if (seg == 0) { rb_ = F.BG[row * 16 + h]; rg_ = F.BG[row * 16 + 8 + h]; } }
        const LAS float* cb = buf + (c & 1) * BS;
        for (int tk = 0; tk < 16; ++tk) {
            const LAS float* tb = cb + tk * TS;
            const float beta = tb[384], eg = tb[385], vv = tb[256 + dv];
            float kk[32];
#pragma unroll
            for (int i = 0; i < 8; ++i) { const f32x4 t4 = *(const LAS f32x4*)(tb + qd * 32 + 4 * i); kk[4 * i] = t4.x; kk[4 * i + 1] = t4.y; kk[4 * i + 2] = t4.z; kk[4 * i + 3] = t4.w; }
            float ks = 0.f;
#pragma unroll
            for (int i = 0; i < 32; ++i) ks += kk[i] * S[i];
            ks += __shfl_xor(ks, 1); ks += __shfl_xor(ks, 2);
            const float vp = beta * (vv - eg * ks);
#pragma unroll
            for (int i = 0; i < 32; ++i) S[i] = eg * S[i] + kk[i] * vp;
            float o = 0.f;
#pragma unroll
            for (int i = 0; i < 8; ++i) { const f32x4 t4 = *(const LAS f32x4*)(tb + 128 + qd * 32 + 4 * i); o += t4.x * S[4 * i] + t4.y * S[4 * i + 1] + t4.z * S[4 * i + 2] + t4.w * S[4 * i + 3]; }
            o += __shfl_xor(o, 1); o += __shfl_xor(o, 2);
            if (qd == 0) OR[(rowbase + (size_t)c * 16 + tk) * 1024 + h * 128 + dv] = o;
        }
        if (more) { LAS float* d = buf + ((c + 1) & 1) * BS + tl * TS;
            *(LAS f32x4*)(d + seg * 4) = (f32x4){bf_lo(rk.x), bf_hi(rk.x), bf_lo(rk.y), bf_hi(rk.y)};
            *(LAS f32x4*)(d + 128 + seg * 4) = (f32x4){bf_lo(rq.x), bf_hi(rq.x), bf_lo(rq.y), bf_hi(rq.y)};
            *(LAS f32x4*)(d + 256 + seg * 4) = (f32x4){bf_lo(rv.x), bf_hi(rv.x), bf_lo(rv.y), bf_hi(rv.y)};
            if (seg == 0) { d[384] = rb_; d[385] = __expf(rg_); } }
        __syncthreads();
    }
}
typedef float f32x2 __attribute__((ext_vector_type(2)));
constexpr int AMP = 68;
__device__ __forceinline__ void g2_unit(Frame& F, const int item, const int p, LAS float* Am, const int lane, const bool dry) {
    const int r32 = lane & 31, hi = lane >> 5;
    LAS float* gcs = Am + 64 * AMP;
    LAS float* bts = gcs + 64;
    bf16* QN = slot(F, 5); const bf16* KN = slot(F, 6); const bf16* VS = (const bf16*)(F.ob + DO_D0);
    bf16* UT = slot(F, 3); bf16* KT = slot(F, 1); bf16* Wb = slot(F, 2); bf16* ATT = (bf16*)(F.ob + DO_BM);
    const bool isW = p != 0, doQ = p == 0;
    const int b = item / 520, rem = item % 520, h = rem / 65, c = rem % 65;
    const size_t r0 = (size_t)b * TP + 64 * c; const int hc = h * 128;
    {   float g = F.BG[(r0 + lane) * 16 + 8 + h]; const float beta = F.BG[(r0 + lane) * 16 + h];
#pragma unroll
        for (int o = 1; o < 64; o <<= 1) { const float t = __int_as_float(__builtin_amdgcn_ds_bpermute((lane - o) << 2, __float_as_int(g))); if (lane >= o) g += t; }
        gcs[lane] = g; bts[lane] = beta;
        if (doQ && lane == 63) F.GL[item] = __expf(g); }
    LDS_WAIT();
    {
        bf16x8 k0f[8], k1f[8];
        {   const bf16* kp0 = KN + (r0 + r32) * 1024 + hc + 8 * hi; const bf16* kp1 = kp0 + 32 * 1024;
#pragma unroll
            for (int ks = 0; ks < 8; ++ks) { k0f[ks] = *(const bf16x8*)(kp0 + 16 * ks); k1f[ks] = *(const bf16x8*)(kp1 + 16 * ks); } }
        bf16x8 q0f[8], q1f[8];
        if (doQ) { const bf16* qp0 = QN + (r0 + r32) * 1024 + hc + 8 * hi; const bf16* qp1 = qp0 + 32 * 1024;
#pragma unroll
            for (int ks = 0; ks < 8; ++ks) { q0f[ks] = *(const bf16x8*)(qp0 + 16 * ks); q1f[ks] = *(const bf16x8*)(qp1 + 16 * ks); } }
#pragma unroll
        for (int tt = 0; tt < 3; ++tt) {
            const int ti = tt > 0 ? 1 : 0, tj = tt == 2 ? 1 : 0;
            f32x16 acc;
#pragma unroll
            for (int i = 0; i < 16; ++i) acc[i] = 0.f;
#pragma unroll
            for (int ks = 0; ks < 8; ++ks) acc = __builtin_amdgcn_mfma_f32_32x32x16_bf16(ti ? k1f[ks] : k0f[ks], tj ? k1f[ks] : k0f[ks], acc, 0, 0, 0);
            const int j = 32 * tj + r32; const float gcj = gcs[j];
#pragma unroll
            for (int rg = 0; rg < 16; ++rg) {
                const int i = 32 * ti + (rg & 3) + 8 * (rg >> 2) + 4 * hi;
                const float e = __expf(i >= j ? gcs[i] - gcj : 0.f);
                Am[i * AMP + j] = (i > j) ? bts[i] * acc[rg] * e : 0.f;
            }
        }
        if (doQ) {
#pragma unroll
            for (int tt = 0; tt < 3; ++tt) {
                const int ti = tt > 0 ? 1 : 0, tj = tt == 2 ? 1 : 0;
                f32x16 acq;
#pragma unroll
                for (int i = 0; i < 16; ++i) acq[i] = 0.f;
#pragma unroll
                for (int ks = 0; ks < 8; ++ks) acq = __builtin_amdgcn_mfma_f32_32x32x16_bf16(ti ? q1f[ks] : q0f[ks], tj ? k1f[ks] : k0f[ks], acq, 0, 0, 0);
                const int j = 32 * tj + r32; const float gcj = gcs[j];
#pragma unroll
                for (int rg = 0; rg < 16; ++rg) {
                    const int i = 32 * ti + (rg & 3) + 8 * (rg >> 2) + 4 * hi;
                    const float e = __expf(i >= j ? gcs[i] - gcj : 0.f);
                    const float v = (i >= j) ? acq[rg] * e : 0.f; ATT[(size_t)item * 4096 + i * 64 + j] = (bf16)(cvtpk(v, 0.f) & 0xffffu);
                }
            }
        }
    }
    asm volatile("" ::: "memory");
    if (doQ) {
        const u32x4 z = {0u, 0u, 0u, 0u};
        u32x4* d = (u32x4*)(ATT + (size_t)item * 4096 + (lane >> 1) * 64 + 32 + 16 * (lane & 1)); d[0] = z; d[1] = z;
        const float eg = __expf(gcs[lane]);
        u32x4* qp = (u32x4*)(QN + (r0 + lane) * 1024 + hc);
        u32x4 qv[16];
#pragma unroll
        for (int k = 0; k < 16; ++k) qv[k] = qp[k];
#pragma unroll
        for (int k = 0; k < 16; ++k) { u32x4 v = qv[k];
            v.x = cvtpk(bf_lo(v.x) * eg, bf_hi(v.x) * eg); v.y = cvtpk(bf_lo(v.y) * eg, bf_hi(v.y) * eg); v.z = cvtpk(bf_lo(v.z) * eg, bf_hi(v.z) * eg); v.w = cvtpk(bf_lo(v.w) * eg, bf_hi(v.w) * eg);
            if (!dry) qp[k] = v; else asm volatile("" :: "v"(v.x), "v"(v.y), "v"(v.z), "v"(v.w)); }
    }
    asm volatile("" ::: "memory");
    f32x2 x[64];
    {   const bf16* src = (isW ? KN : VS) + r0 * 1024 + hc + 2 * lane;
        const float gl = gcs[63], fW = isW ? 1.f : 0.f;
        unsigned raw[64];
#pragma unroll
        for (int i = 0; i < 64; ++i) raw[i] = *(const unsigned*)(src + (size_t)i * 1024);
        if (isW) {
            u32x4* d0 = (u32x4*)(KT + (size_t)item * 8192 + (2 * lane) * 64); u32x4* d1 = d0 + 8;
#pragma unroll
            for (int k = 0; k < 8; ++k) { float ee[8];
#pragma unroll
                for (int t = 0; t < 8; ++t) ee[t] = __expf(gl - gcs[8 * k + t]);
                u32x4 o0, o1;
                o0.x = cvtpk(bf_lo(raw[8 * k]) * ee[0], bf_lo(raw[8 * k + 1]) * ee[1]); o0.y = cvtpk(bf_lo(raw[8 * k + 2]) * ee[2], bf_lo(raw[8 * k + 3]) * ee[3]);
                o0.z = cvtpk(bf_lo(raw[8 * k + 4]) * ee[4], bf_lo(raw[8 * k + 5]) * ee[5]); o0.w = cvtpk(bf_lo(raw[8 * k + 6]) * ee[6], bf_lo(raw[8 * k + 7]) * ee[7]);
                o1.x = cvtpk(bf_hi(raw[8 * k]) * ee[0], bf_hi(raw[8 * k + 1]) * ee[1]); o1.y = cvtpk(bf_hi(raw[8 * k + 2]) * ee[2], bf_hi(raw[8 * k + 3]) * ee[3]);
                o1.z = cvtpk(bf_hi(raw[8 * k + 4]) * ee[4], bf_hi(raw[8 * k + 5]) * ee[5]); o1.w = cvtpk(bf_hi(raw[8 * k + 6]) * ee[6], bf_hi(raw[8 * k + 7]) * ee[7]);
                d0[k] = o0; d1[k] = o1; }
        }
#pragma unroll
        for (int i = 0; i < 64; ++i) { const float sc = bts[i] * __expf(gcs[i] * fW); x[i] = (f32x2){bf_lo(raw[i]) * sc, bf_hi(raw[i]) * sc}; }
    }
    asm volatile("" ::: "memory");
#pragma unroll
    for (int i = 1; i < 64; ++i) {
        f32x2 s0 = x[i], s1 = {0.f, 0.f};
#pragma unroll
        for (int jg = 0; jg < (i + 3) / 4; ++jg) { const f32x4 a4 = *(const LAS f32x4*)(Am + i * AMP + 4 * jg);
            s0 -= a4.x * x[4 * jg]; s1 -= a4.y * x[4 * jg + 1]; s0 -= a4.z * x[4 * jg + 2]; s1 -= a4.w * x[4 * jg + 3]; }
        x[i] = s0 + s1;
        asm volatile("" ::: "memory");
    }
    if (isW) { bf16* dst = Wb + r0 * 1024 + hc + 2 * lane;
#pragma unroll
        for (int i = 0; i < 64; ++i) *(unsigned*)(dst + (size_t)i * 1024) = cvtpk(x[i].x, x[i].y);
    } else { u32x4* d0 = (u32x4*)(UT + (size_t)item * 8192 + (2 * lane) * 64); u32x4* d1 = d0 + 8;
#pragma unroll
        for (int k = 0; k < 8; ++k) { u32x4 o0, o1;
            o0.x = cvtpk(x[8 * k].x, x[8 * k + 1].x); o0.y = cvtpk(x[8 * k + 2].x, x[8 * k + 3].x); o0.z = cvtpk(x[8 * k + 4].x, x[8 * k + 5].x); o0.w = cvtpk(x[8 * k + 6].x, x[8 * k + 7].x);
            o1.x = cvtpk(x[8 * k].y, x[8 * k + 1].y); o1.y = cvtpk(x[8 * k + 2].y, x[8 * k + 3].y); o1.z = cvtpk(x[8 * k + 4].y, x[8 * k + 5].y); o1.w = cvtpk(x[8 * k + 6].y, x[8 * k + 7].y);
            d0[k] = o0; d1[k] = o1; }
    }
    LDS_WAIT();
}
__device__ __forceinline__ void g2_phase(Frame& F, const bool dry) {
    LAS float* Am = (LAS float*)(F.lds + F.wave * 17920);
    for (int u = F.gw; u < NB * 8 * 65 * 2; u += F.NGW) {
        int lane = F.lane; asm volatile("" : "+v"(lane));
        g2_unit(F, u >> 1, (u + u / F.NGW) & 1, Am, lane, dry);
    }
}

template <int V>
__device__ __forceinline__ void g3_scan(Frame& F) {
    if (blockIdx.x >= 128) return;
    const int bh = blockIdx.x >> 1, dvh = blockIdx.x & 1, b = bh >> 3, h = bh & 7;
    const int tid = F.tid, lane = F.lane, w = F.wave, r32 = lane & 31, hi = lane >> 5;
    const int qrole = w >> 2, mi = (w >> 1) & 1, ni = w & 1, di = w >> 1;
    LAS bf16* Wl = (LAS bf16*)F.lds;
    LAS bf16* Ql = Wl + 64 * 136;
    LAS bf16* Kl = Ql + 64 * 136;
    LAS bf16* Al = Kl + 2 * 128 * 72;
    LAS bf16* Sl = Al + 2 * 64 * 72;
    LAS bf16* Vl = Sl + 2 * 64 * 136;
    LAS float* glv = (LAS float*)(Vl + 64 * 72);
    const bf16* Wg = slot(F, 2); const bf16* Qg = slot(F, 5); const bf16* KTg = slot(F, 1); const bf16* ATg = (const bf16*)(F.ob + DO_BM); const bf16* UTg = slot(F, 3);
    bf16* Og = (bf16*)(F.ob + DO_D0);
    const int hc = h * 128, dvb = 64 * dvh, item0 = bh * 65;
    f32x16 Sa;
#pragma unroll
    for (int i = 0; i < 16; ++i) Sa[i] = 0.f;
    { const u32x4 z = {0u, 0u, 0u, 0u}; for (int xx = tid; xx < 64 * 136 / 8; xx += 512) *(LAS u32x4*)(Sl + 8 * xx) = z; }
    if (tid < 65) glv[tid] = F.GL[item0 + tid];
    u32x4 pA[7], pB[7]; u32x2 uE[4], uO[4];
#define G3_LOAD(SET, cc_) do { const int ccl_ = (cc_) < 65 ? (cc_) : 64; const int item_ = item0 + ccl_; const size_t r0_ = (size_t)b * TP + 64 * ccl_; \
        _Pragma("unroll") for (int k_ = 0; k_ < 7; ++k_) { const int x_ = tid + 512 * k_; const u32x4* p_; \
            if (k_ < 2) p_ = (const u32x4*)(Wg + (r0_ + (x_ >> 4)) * 1024 + hc + 8 * (x_ & 15)); \
            else if (k_ < 4) p_ = (const u32x4*)(Qg + (r0_ + ((x_ - 1024) >> 4)) * 1024 + hc + 8 * (x_ & 15)); \
            else if (k_ < 6) p_ = (const u32x4*)(KTg + (size_t)item_ * 8192 + (x_ - 2048) * 8); \
            else p_ = (const u32x4*)(ATg + (size_t)item_ * 4096 + (x_ - 3072) * 8); \
            SET[k_] = *p_; } } while (0)
#define G3_STORE(SET, nb_) do { \
        _Pragma("unroll") for (int k_ = 0; k_ < 7; ++k_) { const int x_ = tid + 512 * k_; LAS u32x4* d_; \
            if (k_ < 2) d_ = (LAS u32x4*)(Wl + (x_ >> 4) * 136 + 8 * (x_ & 15)); \
            else if (k_ < 4) d_ = (LAS u32x4*)(Ql + ((x_ - 1024) >> 4) * 136 + 8 * (x_ & 15)); \
            else if (k_ < 6) d_ = (LAS u32x4*)(Kl + (nb_) * (128 * 72) + ((x_ - 2048) >> 3) * 72 + 8 * (x_ & 7)); \
            else d_ = (LAS u32x4*)(Al + (nb_) * (64 * 72) + ((x_ - 3072) >> 3) * 72 + 8 * (x_ & 7)); \
            *d_ = SET[k_]; } } while (0)
#define G3_LOADU(SET, cc_) do { const int ccl_ = (cc_) < 65 ? (cc_) : 64; \
        _Pragma("unroll") for (int q = 0; q < 4; ++q) SET[q] = *(const u32x2*)(UTg + (size_t)(item0 + ccl_) * 8192 + (dvb + 32 * ni + r32) * 64 + 32 * mi + 8 * q + 4 * hi); } while (0)
#define G3_STEP(c_, cb_, PNEXT, PLOAD, UCUR) do { const int cc = (c_); const size_t r0 = (size_t)b * TP + 64 * cc; \
        G3_LOAD(PLOAD, cc + 2); \
        f32x16 acc; _Pragma("unroll") for (int i = 0; i < 16; ++i) acc[i] = 0.f; \
        { const LAS bf16* ap = (qrole ? Ql : Wl) + (32 * mi + r32) * 136 + 8 * hi; const LAS bf16* sp = Sl + (cb_) * (64 * 136) + (32 * ni + r32) * 136 + 8 * hi; \
          _Pragma("unroll") for (int ks = 0; ks < 8; ++ks) { const bf16x8 aX = *(const LAS bf16x8*)(ap + 16 * ks); const bf16x8 bS = *(const LAS bf16x8*)(sp + 16 * ks); acc = __builtin_amdgcn_mfma_f32_32x32x16_bf16(aX, bS, acc, 0, 0, 0); } } \
        if (!qrole) { \
            _Pragma("unroll") for (int q = 0; q < 4; ++q) { \
                const float v0 = bf_lo(UCUR[q].x) - acc[4 * q], v1 = bf_hi(UCUR[q].x) - acc[4 * q + 1], v2 = bf_lo(UCUR[q].y) - acc[4 * q + 2], v3 = bf_hi(UCUR[q].y) - acc[4 * q + 3]; \
                u32x2 pk; pk.x = cvtpk(v0, v1); pk.y = cvtpk(v2, v3); \
                *(LAS u32x2*)(Vl + (32 * ni + r32) * 72 + 32 * mi + 8 * q + 4 * hi) = pk; } \
            G3_LOADU(UCUR, cc + 2); } \
        __syncthreads();                                            \
        if (cc + 1 < 65) G3_STORE(PNEXT, (cb_) ^ 1);                \
        { const float gl = glv[cc]; _Pragma("unroll") for (int i = 0; i < 16; ++i) Sa[i] *= gl; } \
        { const LAS bf16* vp = Vl + (32 * ni + r32) * 72 + 8 * hi; const LAS bf16* kp = Kl + (cb_) * (128 * 72) + (32 * di + r32) * 72 + 8 * hi; const LAS bf16* tp = Al + (cb_) * (64 * 72) + (32 * mi + r32) * 72 + 8 * hi; \
          _Pragma("unroll") for (int ks = 0; ks < 4; ++ks) { const bf16x8 bV = *(const LAS bf16x8*)(vp + 16 * ks); const bf16x8 aK = *(const LAS bf16x8*)(kp + 16 * ks); \
              Sa = __builtin_amdgcn_mfma_f32_32x32x16_bf16(aK, bV, Sa, 0, 0, 0); \
              if (qrole) { const bf16x8 aA = *(const LAS bf16x8*)(tp + 16 * ks); acc = __builtin_amdgcn_mfma_f32_32x32x16_bf16(aA, bV, acc, 0, 0, 0); } } } \
        _Pragma("unroll") for (int q = 0; q < 4; ++q) { u32x2 p0; p0.x = cvtpk(Sa[4 * q], Sa[4 * q + 1]); p0.y = cvtpk(Sa[4 * q + 2], Sa[4 * q + 3]); \
            *(LAS u32x2*)(Sl + ((cb_) ^ 1) * (64 * 136) + (32 * ni + r32) * 136 + 32 * di + 8 * q + 4 * hi) = p0; } \
        if (qrole) { _Pragma("unroll") for (int rg = 0; rg < 16; ++rg) { const int i = 32 * mi + (rg & 3) + 8 * (rg >> 2) + 4 * hi; \
            if (!(V & 1)) Og[(r0 + i) * 1024 + hc + dvb + 32 * ni + r32] = (bf16)(cvtpk(acc[rg], 0.f) & 0xffffu); else asm volatile("" :: "v"(acc[rg])); } } \
        __syncthreads();                                            \
    } while (0)
    G3_LOAD(pA, 0); G3_STORE(pA, 0);
    G3_LOAD(pB, 1);
    G3_LOADU(uE, 0); G3_LOADU(uO, 1);
    __syncthreads();
    for (int c = 0; c < 64; c += 2) {
        G3_STEP(c, 0, pB, pA, uE);
        G3_STEP(c + 1, 1, pA, pB, uO);
    }
    G3_STEP(64, 0, pB, pA, uE);
#undef G3_LOAD
#undef G3_STORE
#undef G3_LOADU
#undef G3_STEP
}

__device__ __forceinline__ void ygdn_phase(Frame& F) {
    const int lane = F.lane;
    bf16* Y = (bf16*)(F.ob + DO_D0); const bf16* GZ = slot(F, 4);
    float nw[16];
    { const f32x4* np = (const f32x4*)(F.gdn_norm + 16 * (lane & 7));
#pragma unroll
      for (int i = 0; i < 4; ++i) { const f32x4 t = np[i]; nw[4 * i] = t.x; nw[4 * i + 1] = t.y; nw[4 * i + 2] = t.z; nw[4 * i + 3] = t.w; } }
    for (int q0 = F.gw * 2; q0 < NB * SEQ; q0 += F.NGW * 2) {
        u32x4 oa[2], oc[2], za[2], zc[2];
#pragma unroll
        for (int k = 0; k < 2; ++k) { const int q = q0 + k; const size_t r = (size_t)(q >> 12) * TP + ROW0 + (q & 4095);
            oa[k] = *(const u32x4*)(Y + r * 1024 + 16 * lane); oc[k] = *(const u32x4*)(Y + r * 1024 + 16 * lane + 8);
            za[k] = *(const u32x4*)(GZ + r * 1024 + 16 * lane); zc[k] = *(const u32x4*)(GZ + r * 1024 + 16 * lane + 8); }
#pragma unroll
        for (int k = 0; k < 2; ++k) { const int q = q0 + k; const size_t r = (size_t)(q >> 12) * TP + ROW0 + (q & 4095);
            float o[16], z[16]; g1_unpack16(oa[k], oc[k], o); g1_unpack16(za[k], zc[k], z);
            float ss = 0.f;
#pragma unroll
            for (int i = 0; i < 16; ++i) ss += o[i] * o[i];
            ss += __shfl_xor(ss, 1); ss += __shfl_xor(ss, 2); ss += __shfl_xor(ss, 4);
            const float rs = 1.0f / sqrtf(ss * (1.f / 128.f) + EPS);
            float y[16];
#pragma unroll
            for (int i = 0; i < 16; ++i) y[i] = o[i] * rs * nw[i] * (z[i] * __builtin_amdgcn_rcpf(1.0f + __expf(-z[i])));
            u32x4 w0, w1;
            w0.x = cvtpk(y[0], y[1]); w0.y = cvtpk(y[2], y[3]); w0.z = cvtpk(y[4], y[5]); w0.w = cvtpk(y[6], y[7]);
            w1.x = cvtpk(y[8], y[9]); w1.y = cvtpk(y[10], y[11]); w1.z = cvtpk(y[12], y[13]); w1.w = cvtpk(y[14], y[15]);
            u32x4* d = (u32x4*)(Y + r * 1024 + 16 * lane); d[0] = w0; d[1] = w1;
        }
    }
}

constexpr int SCW = 4160;
__device__ __forceinline__ unsigned f2key(float f) { const unsigned u = __float_as_uint(f); return (u & 0x80000000u) ? ~u : (u | 0x80000000u); }
#define KEYCNT(expr_) do { _Pragma("unroll") for (int i_ = 0; i_ < 65; ++i_) { if ((i_ & 7) == 0 && i_ >= n64) break; cnt += __builtin_popcountll(__ballot(expr_)); } } while (0)
template <int V>
__device__ __forceinline__ void idx_phase(Frame& F) {
    LAS float* sc = (LAS float*)F.lds;
    const int lane = F.lane, w = F.wave, r32 = lane & 31, hi = lane >> 5;
    const bf16* IQ = slot(F, 2) + (size_t)M_ALL * 512;
    const float NEG_INF = -__builtin_inff();
    for (int item = blockIdx.x; item < NB * 512; item += F.G) {
        const int b = item & 7, qb = 511 - (item >> 3);
        const int t0 = NMETA + 8 * qb, tmax = t0 + 7;
        const size_t rowq = (size_t)b * TP + PADF + t0;
        const int nt32 = (tmax >> 5) + 1, n64 = (tmax >> 6) + 1, nt32p = 2 * n64;
        bf16x8 af[2][4]; float wv[2][16];
#pragma unroll
        for (int tile = 0; tile < 2; ++tile) {
            const int tok = tile * 4 + (r32 >> 3), head = r32 & 7;
            const bf16* p = IQ + (rowq + tok) * 512 + head * 64 + 8 * hi;
#pragma unroll
            for (int ks = 0; ks < 4; ++ks) af[tile][ks] = *(const bf16x8*)(p + 16 * ks);
#pragma unroll
            for (int j = 0; j < 4; ++j) { const f32x4 t4 = *(const f32x4*)(F.SMALL + (rowq + tile * 4 + j) * 128 + 64 + 4 * hi); wv[tile][4 * j] = t4.x; wv[tile][4 * j + 1] = t4.y; wv[tile][4 * j + 2] = t4.z; wv[tile][4 * j + 3] = t4.w; }
        }
        const bf16* kbase = F.IKB + (size_t)b * 130 * 2048 + hi * 256 + r32 * 8;
#define IDX_LOADT(SET, kt_) do { const int kn_ = (kt_) < nt32 ? (kt_) : nt32 - 1; \
            _Pragma("unroll") for (int ks = 0; ks < 4; ++ks) SET[ks] = *(const bf16x8*)(kbase + (size_t)kn_ * 2048 + ks * 512); } while (0)
#define IDX_RELU(x_) __int_as_float(max(__float_as_int(x_), 0))
#define IDX_TILE(SET, kt_) do { const int ktc_ = (kt_); if (ktc_ < nt32p) { const int s = ktc_ * 32 + r32; \
            if (ktc_ < nt32) { \
                f32x16 a0, a1; \
                _Pragma("unroll") for (int i = 0; i < 16; ++i) { a0[i] = 0.f; a1[i] = 0.f; } \
                _Pragma("unroll") for (int ks = 0; ks < 4; ++ks) { a0 = __builtin_amdgcn_mfma_f32_32x32x16_bf16(af[0][ks], SET[ks], a0, 0, 0, 0); a1 = __builtin_amdgcn_mfma_f32_32x32x16_bf16(af[1][ks], SET[ks], a1, 0, 0, 0); } \
                float pv_[4]; \
                _Pragma("unroll") for (int j = 0; j < 4; ++j) { \
                    const float x0_ = wv[0][4 * j] * IDX_RELU(a0[4 * j]) + wv[0][4 * j + 1] * IDX_RELU(a0[4 * j + 1]) + wv[0][4 * j + 2] * IDX_RELU(a0[4 * j + 2]) + wv[0][4 * j + 3] * IDX_RELU(a0[4 * j + 3]); \
                    const float x1_ = wv[1][4 * j] * IDX_RELU(a1[4 * j]) + wv[1][4 * j + 1] * IDX_RELU(a1[4 * j + 1]) + wv[1][4 * j + 2] * IDX_RELU(a1[4 * j + 2]) + wv[1][4 * j + 3] * IDX_RELU(a1[4 * j + 3]); \
                      \
                    const auto rr_ = __builtin_amdgcn_permlane32_swap(__float_as_uint(x0_), __float_as_uint(x1_), false, false); \
                    pv_[j] = __uint_as_float(rr_[0]) + __uint_as_float(rr_[1]); } \
                _Pragma("unroll") for (int j = 0; j < 4; ++j) { const int tok = hi * 4 + j; sc[tok * SCW + s] = (s > t0 + tok) ? NEG_INF : pv_[j]; } \
            } else { \
                _Pragma("unroll") for (int j = 0; j < 4; ++j) sc[(hi * 4 + j) * SCW + s] = NEG_INF; \
            } } } while (0)
        if (!(V & 1)) {
            bf16x8 bA[4], bB[4], bC[4];
            IDX_LOADT(bA, w); IDX_LOADT(bB, w + 8);
            if (V & 4) IDX_LOADT(bC, w + 16);
            for (int kt = w; kt < nt32p; kt += 24) {
                if (!(V & 4)) IDX_LOADT(bC, kt + 16); IDX_TILE(bA, kt);
                if (!(V & 4)) IDX_LOADT(bA, kt + 24); IDX_TILE(bB, kt + 8);
                if (!(V & 4)) IDX_LOADT(bB, kt + 32); IDX_TILE(bC, kt + 16);
            }
        }
#undef IDX_LOADT
#undef IDX_RELU
#undef IDX_TILE
        __syncthreads();
        if (!(V & 2))
        {
            const int t = t0 + w;
            u64 myword = 0ull, word64 = 0ull;
            if (t + 1 <= 256) {
                const int nb = t + 1 - 64 * lane; myword = nb >= 64 ? ~0ull : (nb > 0 ? ((1ull << nb) - 1ull) : 0ull);
            } else {
                unsigned key[65];
#pragma unroll
                for (int i = 0; i < 65; ++i) { const float v = sc[w * SCW + 64 * i + lane]; key[i] = f2key(v) & (unsigned)-(int)(i < n64); }
                unsigned prefix = 0u; bool exact = false;
                for (int bit = 31; bit >= 0; --bit) {
                    const unsigned cand = prefix | (1u << bit); int cnt = 0;
                    KEYCNT(key[i_] >= cand);
                    if (cnt >= 256) { prefix = cand; if (cnt == 256) { exact = true; break; } }
                }
                int need = 0;
                if (!exact) { int cnt = 0; KEYCNT(key[i_] >= prefix); if (cnt == 256) exact = true; else { cnt = 0; KEYCNT(key[i_] > prefix); need = 256 - cnt; } }
#pragma unroll
                for (int i = 0; i < 65; ++i) {
                    u64 m;
                    if (exact) m = __ballot(key[i] >= prefix);
                    else {
                        m = __ballot(key[i] > prefix); u64 eq = __ballot(key[i] == prefix);
                        if (need > 0 && eq != 0ull) { const int c = __builtin_popcountll(eq);
                            if (c <= need) { m |= eq; need -= c; }
                            else { u64 tk = 0ull; for (int z = 0; z < need; ++z) { const u64 lb = eq & (0ull - eq); tk |= lb; eq ^= lb; } m |= tk; need = 0; } }
                    }
                    if (i < 64) myword = (lane == i) ? m : myword; else word64 = m;
                }
            }
            u64* dst = F.BM + ((size_t)b * SEQ + (t - NMETA)) * 65;
            dst[lane] = myword; if (lane == 0) dst[64] = word64;
        }
        __syncthreads();
    }
}

__device__ __forceinline__ void attn_naive(Frame& F) {
    const int lane = F.lane, w = F.wave;
    LAS float* qf = (LAS float*)(F.lds + w * 13312);
    LAS float* P = qf + 1024;
    LAS int* list = (LAS int*)(P + 2048);
    const bf16* AQ = slot(F, 1); const bf16* AKV = slot(F, 2); bf16* Y = slot(F, 6);
    const float NEG_INF = -__builtin_inff();
    for (int qi = F.gw; qi < NB * SEQ; qi += F.NGW) {
        const int b = qi >> 12, j = qi & 4095;
        const size_t row = (size_t)b * TP + ROW0 + j; const size_t krow0 = (size_t)b * TP + PADF;
        {   const u32x4 a = *(const u32x4*)(AQ + row * 1024 + 16 * lane), c = *(const u32x4*)(AQ + row * 1024 + 16 * lane + 8);
            LAS f32x4* d = (LAS f32x4*)(qf + 16 * lane);
            d[0] = (f32x4){bf_lo(a.x), bf_hi(a.x), bf_lo(a.y), bf_hi(a.y)}; d[1] = (f32x4){bf_lo(a.z), bf_hi(a.z), bf_lo(a.w), bf_hi(a.w)};
            d[2] = (f32x4){bf_lo(c.x), bf_hi(c.x), bf_lo(c.y), bf_hi(c.y)}; d[3] = (f32x4){bf_lo(c.z), bf_hi(c.z), bf_lo(c.w), bf_hi(c.w)}; }
        const u64* bm = F.BM + (size_t)qi * 65;
        int nsel = 0;
        for (int i = 0; i < 65; ++i) { const u64 m = bm[i]; if ((m >> lane) & 1ull) list[nsel + __builtin_popcountll(m & ((1ull << lane) - 1ull))] = 64 * i + lane; nsel += __builtin_popcountll(m); }
        nsel = nsel > 256 ? 256 : nsel;
        LDS_WAIT();
        for (int rr = 0; rr < 4; ++rr) {
            const int jj = 64 * rr + lane; const bool valid = jj < nsel; const int s = valid ? list[jj] : 0;
            const bf16* kp = AKV + (krow0 + s) * 512;
            float a[8];
#pragma unroll
            for (int i = 0; i < 8; ++i) a[i] = 0.f;
#pragma unroll 4
            for (int c = 0; c < 16; ++c) {
                const u32x4 k0 = *(const u32x4*)(kp + 8 * c), k1 = *(const u32x4*)(kp + 128 + 8 * c);
                const float kf0[8] = {bf_lo(k0.x), bf_hi(k0.x), bf_lo(k0.y), bf_hi(k0.y), bf_lo(k0.z), bf_hi(k0.z), bf_lo(k0.w), bf_hi(k0.w)};
                const float kf1[8] = {bf_lo(k1.x), bf_hi(k1.x), bf_lo(k1.y), bf_hi(k1.y), bf_lo(k1.z), bf_hi(k1.z), bf_lo(k1.w), bf_hi(k1.w)};
#pragma unroll
                for (int hh = 0; hh < 4; ++hh) {
                    const f32x4 qa = *(const LAS f32x4*)(qf + hh * 128 + 8 * c), qb = *(const LAS f32x4*)(qf + hh * 128 + 8 * c + 4);
                    a[hh] += kf0[0] * qa.x + kf0[1] * qa.y + kf0[2] * qa.z + kf0[3] * qa.w + kf0[4] * qb.x + kf0[5] * qb.y + kf0[6] * qb.z + kf0[7] * qb.w;
                    const f32x4 qc = *(const LAS f32x4*)(qf + (4 + hh) * 128 + 8 * c), qd = *(const LAS f32x4*)(qf + (4 + hh) * 128 + 8 * c + 4);
                    a[4 + hh] += kf1[0] * qc.x + kf1[1] * qc.y + kf1[2] * qc.z + kf1[3] * qc.w + kf1[4] * qd.x + kf1[5] * qd.y + kf1[6] * qd.z + kf1[7] * qd.w;
                }
            }
#pragma unroll
            for (int hd = 0; hd < 8; ++hd) P[hd * 256 + jj] = valid ? a[hd] * 0.08838834764831845f : NEG_INF;
        }
        LDS_WAIT();
#pragma unroll
        for (int hd = 0; hd < 8; ++hd) {
            float v0 = P[hd * 256 + lane], v1 = P[hd * 256 + 64 + lane], v2 = P[hd * 256 + 128 + lane], v3 = P[hd * 256 + 192 + lane];
            const float mx = wave_max(fmaxf(fmaxf(v0, v1), fmaxf(v2, v3)));
            v0 = __expf(v0 - mx); v1 = __expf(v1 - mx); v2 = __expf(v2 - mx); v3 = __expf(v3 - mx);
            const float inv = 1.0f / wave_sum((v0 + v1) + (v2 + v3));
            P[hd * 256 + lane] = v0 * inv; P[hd * 256 + 64 + lane] = v1 * inv; P[hd * 256 + 128 + lane] = v2 * inv; P[hd * 256 + 192 + lane] = v3 * inv;
        }
        LDS_WAIT();
        const int g = lane >> 5, d0 = (lane & 31) * 4;
        float o[4][4];
#pragma unroll
        for (int hh = 0; hh < 4; ++hh) { o[hh][0] = 0.f; o[hh][1] = 0.f; o[hh][2] = 0.f; o[hh][3] = 0.f; }
#pragma unroll 4
        for (int jj = 0; jj < nsel; ++jj) {
            const int s = list[jj];
            const u32x2 vv = *(const u32x2*)(AKV + (krow0 + s) * 512 + 256 + g * 128 + d0);
            const float v0 = bf_lo(vv.x), v1 = bf_hi(vv.x), v2 = bf_lo(vv.y), v3 = bf_hi(vv.y);
#pragma unroll
            for (int hh = 0; hh < 4; ++hh) { const float p = P[(4 * g + hh) * 256 + jj]; o[hh][0] += p * v0; o[hh][1] += p * v1; o[hh][2] += p * v2; o[hh][3] += p * v3; }
        }
#pragma unroll
        for (int hh = 0; hh < 4; ++hh) { u32x2 ow; ow.x = cvtpk(o[hh][0], o[hh][1]); ow.y = cvtpk(o[hh][2], o[hh][3]); *(u32x2*)(Y + row * 1024 + (4 * g + hh) * 128 + d0) = ow; }
        LDS_WAIT();
    }
}

namespace att {
constexpr int D = 128, QS = 1024, KVS = 512, OS = 1024;
constexpr bool WSKIP = false;
constexpr float THR = 8.f;
constexpr float SCALE = 0.08838834764831845f;
constexpr int NW = 8, QBLK = 32, KVBLK = 64, QB = NW * QBLK;
constexpr int SHM_V = KVBLK * D * 2, SHM_K = KVBLK * D * 2;
constexpr int LDS_BYTES = 2 * SHM_V + 2 * SHM_K + NW * 64 * 4;
using bf16 = __hip_bfloat16;
typedef short bf16x8 __attribute__((ext_vector_type(8)));
typedef short s16x4 __attribute__((ext_vector_type(4)));
typedef float f32x16 __attribute__((ext_vector_type(16)));
typedef float f32x4 __attribute__((ext_vector_type(4)));
typedef unsigned u32x4 __attribute__((ext_vector_type(4)));
template <class A, class Bt> struct same_t { static constexpr bool v = false; };
template <class A> struct same_t<A, A> { static constexpr bool v = true; };
#define KSWZ(row, colB) ((row) * 256 + ((colB) ^ (((row) & 7) << 4)))
#define SBAR() __builtin_amdgcn_sched_barrier(0)
__device__ __forceinline__ int v_st(int k, int c) { const int kk = (k & ~0xC) | ((k & 4) << 1) | ((k & 8) >> 1); return ((kk >> 3) * 4 + (c >> 5)) * 512 + ((kk & 7) * 32 + (c & 31)) * 2; }
__device__ __forceinline__ int v_rd_base(int lane) { return ((lane & 3) << 3) | (((lane >> 2) & 3) << 6) | (((lane >> 4) & 1) << 5) | (((lane >> 5) & 1) << 8); }
constexpr int v_rd_off(int d0, int ks, int half) { return d0 * 512 + ks * 4096 + half * 2048; }
__device__ __forceinline__ int crow(int r, int hi) { return (r & 3) + 8 * (r >> 2) + 4 * hi; }
__device__ __forceinline__ unsigned cvtpk(float lo, float hi) {
    unsigned r; asm volatile("v_cvt_pk_bf16_f32 %0, %1, %2" : "=v"(r) : "v"(lo), "v"(hi)); return r;
}
__device__ __forceinline__ bf16x8 pack8(f32x4 a, f32x4 b) {
    u32x4 w = {cvtpk(a[0], a[1]), cvtpk(a[2], a[3]), cvtpk(b[0], b[1]), cvtpk(b[2], b[3])};
    return *reinterpret_cast<bf16x8*>(&w);
}
template <class T> __device__ __forceinline__ bf16x8 load8(const T* p) {
    if constexpr (same_t<T, float>::v) { return pack8(*(const f32x4*)p, *(const f32x4*)(p + 4)); }
    else { return *reinterpret_cast<const bf16x8*>(p); }
}
__device__ __forceinline__ void mask_tile(f32x16& p0, f32x16& p1, int dq, unsigned W) {
    const float NEG = -__builtin_inff();
#pragma unroll
    for (int r = 0; r < 16; ++r) {
        const int c = (r & 3) + 8 * (r >> 2);
        if ((unsigned)(dq - c) >= W) p0[r] = NEG;
        if ((unsigned)(dq - c - 32) >= W) p1[r] = NEG;
    }
}
__device__ __forceinline__ void mask_bits(f32x16& p0, f32x16& p1, unsigned long long word, int hi) {
    const float NEG = -__builtin_inff();
    const unsigned lo = (unsigned)(word >> (4 * hi)), up = (unsigned)(word >> (32 + 4 * hi));
#pragma unroll
    for (int r = 0; r < 16; ++r) {
        const unsigned bit = 1u << ((r & 3) + 8 * (r >> 2));
        if (!(lo & bit)) p0[r] = NEG;
        if (!(up & bit)) p1[r] = NEG;
    }
}
__device__ __forceinline__ void partialSM(f32x16& p0, f32x16& p1, float& m_reg, float& mn, float& alpha) {
    float pmax = p0[0]; for (int r = 1; r < 16; ++r) pmax = fmaxf(pmax, p0[r]); for (int r = 0; r < 16; ++r) pmax = fmaxf(pmax, p1[r]);
    { auto rr = __builtin_amdgcn_permlane32_swap(__float_as_uint(pmax), __float_as_uint(pmax), false, false);
      pmax = fmaxf(__uint_as_float(rr[0]), __uint_as_float(rr[1])); }
    constexpr float C2 = 1.4426950408889634f * SCALE;
    if (__builtin_expect(__all((pmax - m_reg) * SCALE <= THR), 1)) { mn = m_reg; alpha = 1.f; }
    else { mn = fmaxf(m_reg, pmax); alpha = __builtin_amdgcn_exp2f((m_reg - mn) * C2); m_reg = mn; }
    const float mnL = -mn * C2;
    for (int r = 0; r < 16; ++r) p0[r] = fmaf(p0[r], C2, mnL); for (int r = 0; r < 16; ++r) p1[r] = fmaf(p1[r], C2, mnL);
    for (int r = 0; r < 16; ++r) p0[r] = __builtin_amdgcn_exp2f(p0[r]);
}
__device__ __forceinline__ void finishSM(f32x16& p0, f32x16& p1, float alpha, float& l_reg, bf16x8& pa0, bf16x8& pa1, bf16x8& pa2, bf16x8& pa3) {
    for (int r = 0; r < 16; ++r) p1[r] = __builtin_amdgcn_exp2f(p1[r]);
    float ps = 0; for (int r = 0; r < 16; ++r) ps += p0[r]; for (int r = 0; r < 16; ++r) ps += p1[r];
    { auto rr = __builtin_amdgcn_permlane32_swap(__float_as_uint(ps), __float_as_uint(ps), false, false);
      ps = __uint_as_float(rr[0]) + __uint_as_float(rr[1]); }
    l_reg = l_reg * alpha + ps;
#define PK4(P, B_, OUT) do { unsigned a0 = cvtpk(P[B_+0], P[B_+1]), a1 = cvtpk(P[B_+2], P[B_+3]);                          \
        unsigned b0 = cvtpk(P[B_+4], P[B_+5]), b1 = cvtpk(P[B_+6], P[B_+7]);                                             \
        auto r0 = __builtin_amdgcn_permlane32_swap(a0, b0, false, false); auto r1 = __builtin_amdgcn_permlane32_swap(a1, b1, false, false); \
        u32x4 w = {r0[0], r1[0], r0[1], r1[1]}; OUT = *reinterpret_cast<bf16x8*>(&w); } while (0)
    PK4(p0, 0, pa0); PK4(p0, 8, pa1); PK4(p1, 0, pa2); PK4(p1, 8, pa3);
#undef PK4
}
template <int KB, bool SK>
__device__ __forceinline__ void qkt(f32x16& p0, f32x16& p1, const char* K_lds, int r32, int hi, const bf16x8* qr, const char* ql, bool act) {
    if (SK && !act) { const float NEG = -__builtin_inff();
#pragma unroll
        for (int r = 0; r < 16; ++r) { p0[r] = NEG; p1[r] = NEG; } return; }
    p0 = f32x16{}; p1 = f32x16{};
    const char* kb[4];
#pragma unroll
    for (int dd = 0; dd < 4; ++dd) kb[dd] = K_lds + KB * SHM_K + KSWZ(r32, (dd * 16 + hi * 8) * 2);
#pragma unroll
    for (int d0 = 0; d0 < 8; ++d0) { const char* a = kb[d0 & 3] + (d0 >> 2) * 128;
        bf16x8 b0 = *reinterpret_cast<const bf16x8*>(a);
        bf16x8 b1 = *reinterpret_cast<const bf16x8*>(a + 32 * 256);
        const bf16x8 qv = d0 < 2 ? qr[d0] : *reinterpret_cast<const bf16x8*>(ql + (d0 - 2) * 1024);
        p0 = __builtin_amdgcn_mfma_f32_32x32x16_bf16(b0, qv, p0, 0, 0, 0);
        p1 = __builtin_amdgcn_mfma_f32_32x32x16_bf16(b1, qv, p1, 0, 0, 0); }
}
template <int VB, bool SK>
__device__ __forceinline__ void pv_tile(f32x16* o, int vb0, bf16x8 pa0, bf16x8 pa1, bf16x8 pa2, bf16x8 pa3, bool act) {
    if (SK && !act) return;
#define TRRD(dst, off) asm volatile("ds_read_b64_tr_b16 %0, %1 offset:%2" : "=&v"(dst) : "v"(vb0), "i"(off) : "memory")
#define PV_D0(d0) do { s16x4 l0, l1, l2, l3, h0, h1, h2, h3; constexpr int b_ = VB * SHM_V + v_rd_off(d0, 0, 0);     \
        TRRD(l0, b_); TRRD(h0, b_ + 2048); TRRD(l1, b_ + 4096); TRRD(h1, b_ + 6144); TRRD(l2, b_ + 8192); TRRD(h2, b_ + 10240); TRRD(l3, b_ + 12288); TRRD(h3, b_ + 14336); \
        asm volatile("s_waitcnt lgkmcnt(0)" ::: "memory"); SBAR();                 \
        o[d0] = __builtin_amdgcn_mfma_f32_32x32x16_bf16(pa0, (bf16x8){l0[0], l0[1], l0[2], l0[3], h0[0], h0[1], h0[2], h0[3]}, o[d0], 0, 0, 0);   \
        o[d0] = __builtin_amdgcn_mfma_f32_32x32x16_bf16(pa1, (bf16x8){l1[0], l1[1], l1[2], l1[3], h1[0], h1[1], h1[2], h1[3]}, o[d0], 0, 0, 0);   \
        o[d0] = __builtin_amdgcn_mfma_f32_32x32x16_bf16(pa2, (bf16x8){l2[0], l2[1], l2[2], l2[3], h2[0], h2[1], h2[2], h2[3]}, o[d0], 0, 0, 0);   \
        o[d0] = __builtin_amdgcn_mfma_f32_32x32x16_bf16(pa3, (bf16x8){l3[0], l3[1], l3[2], l3[3], h3[0], h3[1], h3[2], h3[3]}, o[d0], 0, 0, 0); } while (0)
    PV_D0(0); PV_D0(1); PV_D0(2); PV_D0(3);
#undef PV_D0
#undef TRRD
}

template <class TIn, class TOut> struct BlockRef { const TIn* Q; const TIn* K; const TIn* V; TOut* O; int P0; const unsigned long long* BM; };
template <class TIn> struct Seam {
    bf16x8 qr[8];
    bf16x8 st_v0, st_v1, st_k0, st_k1; f32x4 sf0, sf1, sf2, sf3;
    f32x4 tq[16];
};
__device__ __forceinline__ int swa_jlo(int P0, int W) { const int lowk = P0 - W + 1; return lowk > 0 ? lowk / KVBLK : 0; }
#define ROW(p, k0, rr) ((p) + (size_t)((k0) + (rr)) * KVS + sc)
#define VMW() asm volatile("s_waitcnt vmcnt(0)" ::: "memory")
#define VMWN(n) asm volatile("s_waitcnt vmcnt(%0)" :: "i"(n) : "memory")
#define SLOAD_H(Kp, Vp, k0) do { S.st_v0 = load8<TIn>(ROW(Vp, k0, sr)); S.st_v1 = load8<TIn>(ROW(Vp, k0, 32 + sr));              \
                         S.st_k0 = load8<TIn>(ROW(Kp, k0, sr)); S.st_k1 = load8<TIn>(ROW(Kp, k0, 32 + sr)); } while (0)
#define SWRITE_HK(bf) do { *(bf16x8*)(K_lds + (bf) * SHM_K + kws) = S.st_k0; *(bf16x8*)(K_lds + (bf) * SHM_K + kws + 32 * 256) = S.st_k1; } while (0)
#define SWRITE_HV(bf) do { *(bf16x8*)(V_lds + (bf) * SHM_V + vst0) = S.st_v0; *(bf16x8*)(V_lds + (bf) * SHM_V + vst1) = S.st_v1; } while (0)
#define SWRITE_H(bf) do { SWRITE_HV(bf); SWRITE_HK(bf); } while (0)
#define SLOAD_F(p, k0) do { S.sf0 = *(const f32x4*)ROW(p, k0, sr); S.sf1 = *(const f32x4*)(ROW(p, k0, sr) + 4);                \
                            S.sf2 = *(const f32x4*)ROW(p, k0, 32 + sr); S.sf3 = *(const f32x4*)(ROW(p, k0, 32 + sr) + 4); } while (0)
#define SWRITE_KF(bf) do { *(bf16x8*)(K_lds + (bf) * SHM_K + kws) = pack8(S.sf0, S.sf1); *(bf16x8*)(K_lds + (bf) * SHM_K + kws + 32 * 256) = pack8(S.sf2, S.sf3); } while (0)
#define SWRITE_VF(bf) do { *(bf16x8*)(V_lds + (bf) * SHM_V + vst0) = pack8(S.sf0, S.sf1); *(bf16x8*)(V_lds + (bf) * SHM_V + vst1) = pack8(S.sf2, S.sf3); } while (0)
template <class TIn, class TOut>
__device__ __forceinline__ void causal_swa_prime(const BlockRef<TIn, TOut>& cur, int W, char* lds, Seam<TIn>& S) {
    constexpr bool F32 = same_t<TIn, float>::v;
    const int tid = threadIdx.x, wid = __builtin_amdgcn_readfirstlane(tid >> 6), lane = tid & 63, r32 = lane & 31, hi = lane >> 5;
    const int sr = tid >> 4, sc = (tid & 15) * 8, kws = KSWZ(sr, sc * 2); char* K_lds = lds + 2 * SHM_V;
    const int kb0 = swa_jlo(cur.P0, W) * KVBLK;
    for (int d0 = 0; d0 < 8; ++d0) S.qr[d0] = load8<TIn>(cur.Q + (size_t)(wid * QBLK + r32) * QS + d0 * 16 + hi * 8);
    if constexpr (F32) { SLOAD_F((const float*)cur.K, kb0); VMW(); SWRITE_KF(0); SBAR(); SLOAD_F((const float*)cur.V, kb0); }
    else { SLOAD_H(cur.K, cur.V, kb0); VMW(); SWRITE_HK(0); }
    __syncthreads();
}
template <class TIn, class TOut>
__device__ __forceinline__ void causal_swa_block(const BlockRef<TIn, TOut>& cur, const BlockRef<TIn, TOut>& nxt, int skv, int W, char* lds, Seam<TIn>& S) {
    constexpr bool F32 = same_t<TIn, float>::v;
    int tid_ = threadIdx.x; asm volatile("" : "+v"(tid_));
    const int tid = tid_, wid = __builtin_amdgcn_readfirstlane(tid >> 6), lane = tid & 63, r32 = lane & 31, hi = lane >> 5;
    const int j_lo = swa_jlo(cur.P0, W);
    int j_hi = (cur.P0 + QB - 1) / KVBLK + 1; if (j_hi > skv / KVBLK) j_hi = skv / KVBLK;
    const int NT = j_hi - j_lo;
    const int kbn = swa_jlo(nxt.P0, W) * KVBLK;
    const unsigned long long* bmrow = cur.BM + (size_t)(wid * QBLK + r32) * 65;
    char* Qw = lds + LDS_BYTES + wid * 6144 + lane * 16;
#pragma unroll
    for (int d0 = 2; d0 < 8; ++d0) *reinterpret_cast<bf16x8*>(Qw + (d0 - 2) * 1024) = S.qr[d0];
    const int qlo = cur.P0 + wid * QBLK, qm = qlo + r32 - 4 * hi;
    char* V_lds = lds; char* K_lds = lds + 2 * SHM_V;
    float* ws = (float*)(lds + 2 * SHM_V + 2 * SHM_K) + wid * 64; float* li_l = ws, * al_l = ws + 32;
    float m_reg = -1e30f, l_reg = 0; f32x16 o[4] = {};
    const int sr = tid >> 4, sc = (tid & 15) * 8, vst0 = v_st(sr, sc), vst1 = v_st(32 + sr, sc), kws = KSWZ(sr, sc * 2);
    const int vb0 = (int)(uintptr_t)V_lds + v_rd_base(lane);
    const TIn* Kh = cur.K; const TIn* Vh = cur.V;
#define RESC(a) do { if (__any((a) < 1.f)) { if (hi == 0) al_l[r32] = (a); asm volatile("s_waitcnt lgkmcnt(0)" ::: "memory");              \
                     for (int d_ = 0; d_ < 4; ++d_) for (int r = 0; r < 16; ++r) o[d_][r] *= al_l[crow(r, hi)]; } } while (0)
#define KBASE(t) ((j_lo + (t)) * KVBLK)
#define ACT(t) (KBASE(t) <= qlo + QBLK - 1 && KBASE(t) + KVBLK - 1 >= qlo - W + 1)
#define MASKT(P0_, P1_, WORD_) do { mask_bits(P0_, P1_, WORD_, hi); } while (0)
    constexpr int NQL = F32 ? 16 : 8;
    constexpr bool SK = WSKIP && !F32;
#define SEAM_K0() do { VMWN(NQL); if constexpr (F32) { SWRITE_KF(0); SBAR(); SLOAD_F((const float*)nxt.V, kbn); } else { SWRITE_HK(0); } SBAR(); } while (0)
    f32x16 pA0, pA1, pB0, pB1; float mnA, mnB, alA, alB; bf16x8 pa0, pa1, pa2, pa3;
    if constexpr (F32) { VMW(); SWRITE_VF(0); SBAR(); } else { SWRITE_HV(0); SBAR(); }
    if (NT > 1) { if constexpr (F32) SLOAD_F((const float*)Kh, KBASE(1)); else SLOAD_H(Kh, Vh, KBASE(1)); }
    unsigned long long bmA = bmrow[j_lo], bmB = bmrow[j_lo + (NT > 1 ? 1 : 0)];
    SBAR(); qkt<0, SK>(pA0, pA1, K_lds, r32, hi, S.qr, Qw, ACT(0));
    if constexpr (F32) { if (NT > 1) { VMW(); SWRITE_KF(1); SBAR(); SLOAD_F((const float*)Vh, KBASE(1)); } }
    MASKT(pA0, pA1, bmA); partialSM(pA0, pA1, m_reg, mnA, alA);
    if (NT > 1) { VMW(); if constexpr (F32) { SWRITE_VF(1); SBAR(); if (NT > 2) SLOAD_F((const float*)Kh, KBASE(2)); } else SWRITE_H(1); }
    __syncthreads();
#define HALF_STEP(PX0, PX1, mnX, alX, PY0, PY1, alY, t, KB, VB, SB, WX, WN) do {                                                      \
        SBAR(); qkt<KB, SK>(PX0, PX1, K_lds, r32, hi, S.qr, Qw, ACT(t));                                             \
        WN = bmrow[j_lo + ((t) + 1 < NT ? (t) + 1 : (t))];                                                                  \
        finishSM(PY0, PY1, alY, l_reg, pa0, pa1, pa2, pa3); SBAR();                                                           \
        if ((t) + 1 < NT) { if constexpr (F32) { VMW(); SWRITE_KF(SB); SBAR(); SLOAD_F((const float*)Vh, KBASE((t) + 1)); }  \
                            else { SLOAD_H(Kh, Vh, KBASE((t) + 1)); } SBAR(); }                                               \
        pv_tile<VB, SK>(o, vb0, pa0, pa1, pa2, pa3, ACT((t) - 1)); MASKT(PX0, PX1, WX); partialSM(PX0, PX1, m_reg, mnX, alX);                                        \
        __syncthreads();                                                                                                      \
        if ((t) + 1 < NT) { VMW(); if constexpr (F32) { SWRITE_VF(SB); SBAR(); if ((t) + 2 < NT) SLOAD_F((const float*)Kh, KBASE((t) + 2)); } \
                            else { SWRITE_H(SB); } }                                                                          \
        RESC(alX); __syncthreads(); } while (0)
    for (int t = 1; t + 1 < NT; t += 2) {
        HALF_STEP(pB0, pB1, mnB, alB, pA0, pA1, alA, t, 1, 0, 0, bmB, bmA);
        HALF_STEP(pA0, pA1, mnA, alA, pB0, pB1, alB, t + 1, 0, 1, 1, bmA, bmB);
    }
    const bool even = (NT & 1) == 0;
    if (even) { SBAR(); qkt<1, SK>(pB0, pB1, K_lds, r32, hi, S.qr, Qw, ACT(NT - 1)); SBAR(); }
#define QROW(e) (nxt.Q + (size_t)(wid * QBLK + r32) * QS + ((e) >> 1) * 16 + hi * 8 + ((e) & 1) * 4)
    if constexpr (F32) { SLOAD_F((const float*)nxt.K, kbn); SBAR();
#pragma unroll
        for (int e = 0; e < 8; ++e) S.tq[e] = *(const f32x4*)QROW(e); }
    else { SLOAD_H(nxt.K, nxt.V, kbn); SBAR();
#pragma unroll
        for (int d0 = 0; d0 < 8; ++d0) S.qr[d0] = load8<TIn>(nxt.Q + (size_t)(wid * QBLK + r32) * QS + d0 * 16 + hi * 8); }
    SBAR();
    finishSM(pA0, pA1, alA, l_reg, pa0, pa1, pa2, pa3); SBAR();
    if constexpr (F32) {
#pragma unroll
        for (int e = 8; e < 16; ++e) S.tq[e] = *(const f32x4*)QROW(e); SBAR(); }
#undef QROW
    pv_tile<0, SK>(o, vb0, pa0, pa1, pa2, pa3, ACT(even ? NT - 2 : NT - 1));
    if (even) { MASKT(pB0, pB1, bmB); partialSM(pB0, pB1, m_reg, mnB, alB); __syncthreads(); RESC(alB);
        finishSM(pB0, pB1, alB, l_reg, pa0, pa1, pa2, pa3); SBAR(); pv_tile<1, SK>(o, vb0, pa0, pa1, pa2, pa3, ACT(NT - 1)); }
    SBAR(); SEAM_K0();
    if (hi == 0) li_l[r32] = l_reg; asm volatile("s_waitcnt lgkmcnt(0)" ::: "memory");
    float rli[16];
#pragma unroll
    for (int r = 0; r < 16; ++r) rli[r] = __builtin_amdgcn_rcpf(li_l[crow(r, hi)]);
    TOut* Ow = cur.O + (size_t)(wid * QBLK) * OS;
#pragma unroll
    for (int r = 0; r < 16; ++r) { const int orow = crow(r, hi);
#pragma unroll
        for (int d0 = 0; d0 < 4; ++d0) { const float v = o[d0][r] * rli[r];
            if constexpr (same_t<TOut, float>::v) { Ow[(size_t)orow * OS + d0 * 32 + r32] = v; }
            else { const float vn = __shfl_xor(v, 1);
                   if ((r32 & 1) == 0) *(unsigned*)(Ow + (size_t)orow * OS + d0 * 32 + r32) = cvtpk(v, vn); } } }
    if constexpr (F32) {
#pragma unroll
        for (int d0 = 0; d0 < 8; ++d0) S.qr[d0] = pack8(S.tq[2 * d0], S.tq[2 * d0 + 1]); }
    __syncthreads();
#undef RESC
#undef KBASE
#undef ACT
#undef MASKT
#undef SEAM_K0
#undef HALF_STEP
}
#undef ROW
#undef VMW
#undef VMWN
#undef SLOAD_H
#undef SWRITE_HK
#undef SWRITE_HV
#undef SWRITE_H
#undef SLOAD_F
#undef SWRITE_KF
#undef SWRITE_VF

#undef KSWZ
#undef SBAR
}

typedef att::BlockRef<att::bf16, att::bf16> AttRef;
__device__ __forceinline__ AttRef att_ref(const att::bf16* AQ, const att::bf16* AKV, att::bf16* Y, const u64* BM, int G, int blk, int seq) {
    const int n = blk + G * (seq >> 1);
    const int b = n & 7, m = n >> 3, h = m >> 3, y = m & 7, qb = (seq & 1) ? 15 - y : y;
    const size_t row0 = (size_t)b * TP + ROW0 + 256 * qb;
    AttRef r; r.Q = AQ + row0 * 1024 + h * 128; r.K = AKV + ((size_t)b * TP + PADF) * 512 + (h >> 2) * 128; r.V = r.K + 256; r.O = Y + row0 * 1024 + h * 128;
    r.P0 = NMETA + 256 * qb; r.BM = BM + ((size_t)b * SEQ + 256 * qb) * 65; return r;
}
__device__ __forceinline__ void attn_dense(Frame& F, char* ldsg) {
    const att::bf16* AQ = (const att::bf16*)slot(F, 1); const att::bf16* AKV = (const att::bf16*)slot(F, 2); att::bf16* Y = (att::bf16*)slot(F, 6);
    const int blk = blockIdx.x, G = F.G;
    const int nitems = (512 - blk + G - 1) / G, nseq = 2 * (nitems > 0 ? nitems : 0);
    if (nseq <= 0) return;
    const int W = 1 << 20;
    att::Seam<att::bf16> S;
    AttRef cur = att_ref(AQ, AKV, Y, F.BM, G, blk, 0);
    att::causal_swa_prime<att::bf16, att::bf16>(cur, W, ldsg, S);
    for (int s = 0; s < nseq; ++s) {
        const AttRef nxt = att_ref(AQ, AKV, Y, F.BM, G, blk, s + 1 < nseq ? s + 1 : s);
        att::causal_swa_block<att::bf16, att::bf16>(cur, nxt, 4160, W, ldsg, S);
        cur = nxt;
    }
}

__device__ __forceinline__ void unpack16(const u32x4& a, const u32x4& c, float (&v)[16]) {
    v[0] = bf_lo(a.x); v[1] = bf_hi(a.x); v[2] = bf_lo(a.y); v[3] = bf_hi(a.y); v[4] = bf_lo(a.z); v[5] = bf_hi(a.z); v[6] = bf_lo(a.w); v[7] = bf_hi(a.w);
    v[8] = bf_lo(c.x); v[9] = bf_hi(c.x); v[10] = bf_lo(c.y); v[11] = bf_hi(c.y); v[12] = bf_lo(c.z); v[13] = bf_hi(c.z); v[14] = bf_lo(c.w); v[15] = bf_hi(c.w);
}
__device__ __forceinline__ void rowpass1(Frame& F) {
    const int lane = F.lane;
    const bf16* MIX = slot(F, 1); bf16* N2 = slot(F, 2);
    const f32x4* gp = (const f32x4*)(F.g_post_mix + 16 * lane); const f32x4* g2 = (const f32x4*)(F.g_pre_mlp + 16 * lane);
    const f32x4 gpa = gp[0], gpb = gp[1], gpc = gp[2], gpd = gp[3], ga = g2[0], gb = g2[1], gc = g2[2], gd = g2[3];
    for (int q0 = F.gw * 4; q0 < NB * SEQ; q0 += F.NGW * 4) {
        u32x4 ma[4], mc[4]; f32x4 xv[4][4];
#pragma unroll
        for (int k = 0; k < 4; ++k) { const int q = q0 + k; const size_t r = (size_t)(q >> 12) * TP + ROW0 + (q & 4095);
            ma[k] = *(const u32x4*)(MIX + r * 1024 + 16 * lane); mc[k] = *(const u32x4*)(MIX + r * 1024 + 16 * lane + 8);
            const f32x4* xp = (const f32x4*)(F.x + (size_t)q * 1024 + 16 * lane); xv[k][0] = xp[0]; xv[k][1] = xp[1]; xv[k][2] = xp[2]; xv[k][3] = xp[3]; }
#pragma unroll
        for (int k = 0; k < 4; ++k) { const int q = q0 + k; const size_t r = (size_t)(q >> 12) * TP + ROW0 + (q & 4095);
            float m[16]; unpack16(ma[k], mc[k], m);
            float ss = 0.f;
#pragma unroll
            for (int i = 0; i < 16; ++i) ss += m[i] * m[i];
            const float rs = 1.0f / sqrtf(wave_sum(ss) * (1.f / 1024.f) + EPS);
            f32x4 h0, h1, h2v, h3;
            h0.x = xv[k][0].x + m[0] * rs * gpa.x; h0.y = xv[k][0].y + m[1] * rs * gpa.y; h0.z = xv[k][0].z + m[2] * rs * gpa.z; h0.w = xv[k][0].w + m[3] * rs * gpa.w;
            h1.x = xv[k][1].x + m[4] * rs * gpb.x; h1.y = xv[k][1].y + m[5] * rs * gpb.y; h1.z = xv[k][1].z + m[6] * rs * gpb.z; h1.w = xv[k][1].w + m[7] * rs * gpb.w;
            h2v.x = xv[k][2].x + m[8] * rs * gpc.x; h2v.y = xv[k][2].y + m[9] * rs * gpc.y; h2v.z = xv[k][2].z + m[10] * rs * gpc.z; h2v.w = xv[k][2].w + m[11] * rs * gpc.w;
            h3.x = xv[k][3].x + m[12] * rs * gpd.x; h3.y = xv[k][3].y + m[13] * rs * gpd.y; h3.z = xv[k][3].z + m[14] * rs * gpd.z; h3.w = xv[k][3].w + m[15] * rs * gpd.w;
            { u32x4 e0, e1;
              e0.x = cvtpk(h0.x, h0.y); e0.y = cvtpk(h0.z, h0.w); e0.z = cvtpk(h1.x, h1.y); e0.w = cvtpk(h1.z, h1.w); e1.x = cvtpk(h2v.x, h2v.y); e1.y = cvtpk(h2v.z, h2v.w); e1.z = cvtpk(h3.x, h3.y); e1.w = cvtpk(h3.z, h3.w);
              u32x4* hp = (u32x4*)(slot(F, 1) + r * 1024 + 16 * lane); hp[0] = e0; hp[1] = e1; }
            const float s2 = (h0.x * h0.x + h0.y * h0.y + h0.z * h0.z + h0.w * h0.w) + (h1.x * h1.x + h1.y * h1.y + h1.z * h1.z + h1.w * h1.w)
                           + (h2v.x * h2v.x + h2v.y * h2v.y + h2v.z * h2v.z + h2v.w * h2v.w) + (h3.x * h3.x + h3.y * h3.y + h3.z * h3.z + h3.w * h3.w);
            const float r2 = 1.0f / sqrtf(wave_sum(s2) * (1.f / 1024.f) + EPS);
            u32x4 w0, w1;
            w0.x = cvtpk(h0.x * r2 * ga.x, h0.y * r2 * ga.y); w0.y = cvtpk(h0.z * r2 * ga.z, h0.w * r2 * ga.w); w0.z = cvtpk(h1.x * r2 * gb.x, h1.y * r2 * gb.y); w0.w = cvtpk(h1.z * r2 * gb.z, h1.w * r2 * gb.w);
            w1.x = cvtpk(h2v.x * r2 * gc.x, h2v.y * r2 * gc.y); w1.y = cvtpk(h2v.z * r2 * gc.z, h2v.w * r2 * gc.w); w1.z = cvtpk(h3.x * r2 * gd.x, h3.y * r2 * gd.y); w1.w = cvtpk(h3.z * r2 * gd.z, h3.w * r2 * gd.w);
            u32x4* d = (u32x4*)(N2 + r * 1024 + 16 * lane); d[0] = w0; d[1] = w1;
        }
    }
}
__device__ __forceinline__ void rowpass2(Frame& F) {
    const int lane = F.lane;
    const bf16* DN = slot(F, 0);
    const f32x4* gp = (const f32x4*)(F.g_post_mlp + 16 * lane);
    const f32x4 gpa = gp[0], gpb = gp[1], gpc = gp[2], gpd = gp[3];
    for (int q0 = F.gw * 4; q0 < NB * SEQ; q0 += F.NGW * 4) {
        u32x4 ma[4], mc[4]; f32x4 hv[4][4];
#pragma unroll
        for (int k = 0; k < 4; ++k) { const int q = q0 + k; const size_t r = (size_t)(q >> 12) * TP + ROW0 + (q & 4095);
            ma[k] = *(const u32x4*)(DN + r * 1024 + 16 * lane); mc[k] = *(const u32x4*)(DN + r * 1024 + 16 * lane + 8);
            const u32x4 ha = *(const u32x4*)(slot(F, 1) + r * 1024 + 16 * lane), hc2 = *(const u32x4*)(slot(F, 1) + r * 1024 + 16 * lane + 8);
            hv[k][0] = (f32x4){bf_lo(ha.x), bf_hi(ha.x), bf_lo(ha.y), bf_hi(ha.y)}; hv[k][1] = (f32x4){bf_lo(ha.z), bf_hi(ha.z), bf_lo(ha.w), bf_hi(ha.w)};
            hv[k][2] = (f32x4){bf_lo(hc2.x), bf_hi(hc2.x), bf_lo(hc2.y), bf_hi(hc2.y)}; hv[k][3] = (f32x4){bf_lo(hc2.z), bf_hi(hc2.z), bf_lo(hc2.w), bf_hi(hc2.w)}; }
#pragma unroll
        for (int k = 0; k < 4; ++k) { const int q = q0 + k;
            float m[16]; unpack16(ma[k], mc[k], m);
            float ss = 0.f;
#pragma unroll
            for (int i = 0; i < 16; ++i) ss += m[i] * m[i];
            const float rs = 1.0f / sqrtf(wave_sum(ss) * (1.f / 1024.f) + EPS);
            f32x4 h0 = hv[k][0], h1 = hv[k][1], h2v = hv[k][2], h3 = hv[k][3];
            h0.x += m[0] * rs * gpa.x; h0.y += m[1] * rs * gpa.y; h0.z += m[2] * rs * gpa.z; h0.w += m[3] * rs * gpa.w;
            h1.x += m[4] * rs * gpb.x; h1.y += m[5] * rs * gpb.y; h1.z += m[6] * rs * gpb.z; h1.w += m[7] * rs * gpb.w;
            h2v.x += m[8] * rs * gpc.x; h2v.y += m[9] * rs * gpc.y; h2v.z += m[10] * rs * gpc.z; h2v.w += m[11] * rs * gpc.w;
            h3.x += m[12] * rs * gpd.x; h3.y += m[13] * rs * gpd.y; h3.z += m[14] * rs * gpd.z; h3.w += m[15] * rs * gpd.w;
            f32x4* op = (f32x4*)(F.out + (size_t)q * 1024 + 16 * lane); op[0] = h0; op[1] = h1; op[2] = h2v; op[3] = h3;
        }
    }
}

__device__ __forceinline__ void meta_kv(Frame& F) {
    const int gt = blockIdx.x * 512 + F.tid;
    if (gt >= 16 * 512 * 16) return;
    const int o = gt >> 4, kp = gt & 15, t = o >> 9, col = o & 511;
    const bf16* nrow = slot(F, 0) + ((size_t)PADF + t) * 1024 + 64 * kp;
    const bf16* wrow = F.WIN + (size_t)(4352 + 1024 + col) * 1024 + 64 * kp;
    float acc = 0.f;
#pragma unroll
    for (int j = 0; j < 8; ++j) { const u32x4 a = *(const u32x4*)(nrow + 8 * j), w = *(const u32x4*)(wrow + 8 * j);
        acc += bf_lo(a.x) * bf_lo(w.x) + bf_hi(a.x) * bf_hi(w.x) + bf_lo(a.y) * bf_lo(w.y) + bf_hi(a.y) * bf_hi(w.y) + bf_lo(a.z) * bf_lo(w.z) + bf_hi(a.z) * bf_hi(w.z) + bf_lo(a.w) * bf_lo(w.w) + bf_hi(a.w) * bf_hi(w.w); }
    acc += __shfl_xor(acc, 1); acc += __shfl_xor(acc, 2); acc += __shfl_xor(acc, 4); acc += __shfl_xor(acc, 8);
    const float other = __shfl_xor(acc, 16);
    float val = acc;
    if (col < 256) { const int i = (col & 127) >> 1; const float cs = F.cosA[t * 64 + i], sn = F.sinA[t * 64 + i];
        val = (col & 1) ? acc * cs + other * sn : acc * cs - other * sn; }
    if (kp == 0) { const bf16 hv = (bf16)(cvtpk(val, 0.f) & 0xffffu);
#pragma unroll
        for (int b = 0; b < NB; ++b) slot(F, 2)[((size_t)b * TP + PADF + t) * 512 + col] = hv; }
}

template <class Epi>
__device__ __forceinline__ void run_gemm(Frame& F, const bf16* A, const bf16* Bt, int K, int rowmode, int nM, int nN, const Epi& E) {
    pg8::Gemm g{A, Bt, K, rowmode}; pg8::StaticOrder S; S.init(nM, nN, F.G, (int)blockIdx.x);
    pg8::gemm_phase<Epi, pg8::StaticOrder, true, true>(F.lds, g, S, E);
}

__device__ __forceinline__ void fill_frame(Frame& F) {
    const __attribute__((address_space(4))) Args* kp = (const __attribute__((address_space(4))) Args*)__builtin_amdgcn_kernarg_segment_ptr();
    asm volatile("" : "+s"(kp));
    F.x = kp->in[0]; F.meta = kp->in[1]; F.g_pre_mix = kp->in[2]; F.w_in = kp->in[3]; F.conv_w = kp->in[4]; F.a_log = kp->in[5]; F.dt_bias = kp->in[6]; F.gdn_norm = kp->in[7];
    F.w_bg = kp->in[8]; F.w_bd = kp->in[9]; F.w_out = kp->in[10]; F.g_post_mix = kp->in[11]; F.g_pre_mlp = kp->in[12]; F.w_up = kp->in[13]; F.w_down = kp->in[14]; F.g_post_mlp = kp->in[15];
    F.out = kp->out; F.ws = kp->ws; F.ob = (unsigned char*)kp->out;
    unsigned char* ws = kp->ws;
    F.cosA = (float*)(ws + TAB_COSA); F.sinA = (float*)(ws + TAB_SINA); F.cosI = (float*)(ws + TAB_COSI); F.sinI = (float*)(ws + TAB_SINI);
    F.BG = (float*)(ws + WS_BG); F.GL = (float*)(ws + WS_GL); F.IKB = (bf16*)(ws + WS_IKB); F.SMALL = (float*)(F.ob + DO_SMALL); F.BM = (u64*)(F.ob + DO_BM);
    F.WIN = (bf16*)(ws + WS_WIN); F.WG = (bf16*)(ws + WS_WG); F.WD = (bf16*)(ws + WS_WD); F.WO = (bf16*)(ws + WS_WO); F.WUP = (bf16*)(ws + WS_WUP); F.WDN = (bf16*)(ws + WS_WDN);
}

__global__ void __launch_bounds__(NWAVES * 64, 2) fwd_kernel(Args args) {
    extern __shared__ __attribute__((aligned(16))) unsigned char lds[];
    Frame F;
    F.lds = (LAS unsigned char*)lds;
    F.tid = threadIdx.x; F.lane = F.tid & 63; F.wave = __builtin_amdgcn_readfirstlane(F.tid >> 6);
    F.G = gridDim.x; F.gw = blockIdx.x * NWAVES + F.wave; F.NGW = F.G * NWAVES;
    volatile LAS unsigned* MISC = (volatile LAS unsigned*)(F.lds + MISC_OFF);
    if (F.tid < 16) MISC[F.tid] = 0u;
    __syncthreads();
    XcdBarrier bar = xcd_barrier_post((unsigned*)(args.ws + WS_CTL) + CW_BAR, MISC + 8);
    const int lo = args.ph_lo, hi = args.ph_hi;
#ifdef ONLY_PHASE
#define IN(k) ((k) == ONLY_PHASE)
#else
#define IN(k) (lo <= (k) && (k) < hi)
#endif
#ifndef REPEAT_MASK
#define REPEAT_MASK 0
#endif
#define NREP(k) (((REPEAT_MASK >> (k)) & 1) ? 2 : 1)
#define SEAM(k) do { if (IN((k) + 1)) xcd_barrier(bar); } while (0)
#define PH_BEGIN(k) _Pragma("nounroll") for (int rep_ = 0; rep_ < NREP(k); ++rep_) { fill_frame(F)
#define PH_END(k) } SEAM(k)

    if (IN(0)) { PH_BEGIN(0); p0_prologue(F); PH_END(0); }
    if (IN(1)) { PH_BEGIN(1); pg8::EpiG E{slot(F, 1), F.SMALL, F.cosI, F.sinI}; run_gemm(F, slot(F, 0), F.WIN, 1024, 0, 130, 17, E); PH_END(1); }
    if (IN(2)) { PH_BEGIN(2); g1_phase(F); PH_END(2); }
    if (IN(3)) { PH_BEGIN(3); g2_phase(F, rep_ + 1 < NREP(3)); PH_END(3); }
#ifndef G3_PROBE
#define G3_PROBE 0
#endif
    if (IN(4)) { PH_BEGIN(4); if (G3_PROBE) { g3_scan<G3_PROBE>(F); __syncthreads(); } g3_scan<0>(F); PH_END(4); }
    if (IN(5)) { PH_BEGIN(5); ygdn_phase(F); } }
    if (IN(6)) { PH_BEGIN(6); pg8::EpiA E{slot(F, 1), slot(F, 2), slot(F, 2) + (size_t)M_ALL * 512, slot(F, 3), slot(F, 5), F.cosA, F.sinA, F.cosI, F.sinI};
        run_gemm(F, slot(F, 0), F.WIN + (size_t)4352 * 1024, 1024, 1, 128, 16, E); meta_kv(F); PH_END(6); }
#ifndef IDX_PROBE
#define IDX_PROBE 0
#endif
    if (IN(7)) { PH_BEGIN(7); if (IDX_PROBE) { idx_phase<IDX_PROBE>(F); __syncthreads(); } idx_phase<0>(F); PH_END(7); }
    if (IN(8)) { PH_BEGIN(8); attn_dense(F, (char*)lds); PH_END(8); }
    if (IN(9)) { PH_BEGIN(9);
        { pg8::EpiOne<pg8::EM_MUL> E{slot(F, 4), 1024, pg8::EpiAux{nullptr, nullptr, slot(F, 3), nullptr}, 1}; run_gemm(F, (const bf16*)(F.ob + DO_D0), F.WG, 1024, 1, 128, 4, E); }
        __syncthreads();
        { pg8::EpiOne<pg8::EM_MULADD> E{slot(F, 0), 1024, pg8::EpiAux{nullptr, nullptr, slot(F, 5), slot(F, 4)}, 1}; run_gemm(F, slot(F, 6), F.WD, 1024, 1, 128, 4, E); }
        PH_END(9); }
    if (IN(10)) { PH_BEGIN(10); pg8::EpiOne<pg8::EM_PLAIN> E{slot(F, 1), 1024, pg8::EpiAux{nullptr, nullptr, nullptr, nullptr}, 1}; run_gemm(F, slot(F, 0), F.WO, 1024, 1, 128, 4, E); PH_END(10); }
    if (IN(11)) { PH_BEGIN(11); rowpass1(F); PH_END(11); }
    if (IN(12)) { PH_BEGIN(12); pg8::EpiOne<pg8::EM_RELU2> E{slot(F, 3), 4096, pg8::EpiAux{nullptr, nullptr, nullptr, nullptr}, 1}; run_gemm(F, slot(F, 2), F.WUP, 1024, 1, 128, 16, E); PH_END(12); }
    if (IN(13)) { PH_BEGIN(13); pg8::EpiOne<pg8::EM_PLAIN> E{slot(F, 0), 1024, pg8::EpiAux{nullptr, nullptr, nullptr, nullptr}, 1}; run_gemm(F, slot(F, 3), F.WDN, 4096, 1, 128, 4, E); PH_END(13); }
    if (IN(14)) { fill_frame(F); rowpass2(F); }
#undef IN
#undef PH_BEGIN
#undef PH_END
#undef SEAM
}

extern "C" void kernel_launch(void* const* d_in, const int* in_sizes, int n_in, void* d_out, int out_size, void* d_ws, size_t ws_size, hipStream_t stream) {
    static int grid = 0;
    if (grid == 0) {
        if (n_in != 16 || out_size != NB * SEQ * DM || ws_size < WS_END) { fprintf(stderr, "kernel_launch: unexpected sizes (n_in %d out %d ws %zu, need %zu)\n", n_in, out_size, ws_size, (size_t)WS_END); grid = -1; return; }
        int dev = 0, cus = 0, per_cu = 0;
        if (hipGetDevice(&dev) != hipSuccess || hipDeviceGetAttribute(&cus, hipDeviceAttributeMultiprocessorCount, dev) != hipSuccess) { grid = -1; return; }
        if (hipFuncSetAttribute((const void*)fwd_kernel, hipFuncAttributeMaxDynamicSharedMemorySize, LDS_BYTES) != hipSuccess) { fprintf(stderr, "kernel_launch: hipFuncSetAttribute failed\n"); grid = -1; return; }
        if (hipOccupancyMaxActiveBlocksPerMultiprocessor(&per_cu, (const void*)fwd_kernel, NWAVES * 64, LDS_BYTES) != hipSuccess || per_cu < 1) { fprintf(stderr, "kernel_launch: occupancy query says %d\n", per_cu); per_cu = 1; }
        (void)hipGetLastError();
        grid = cus;
    }
    if (grid < 0) return;
    if (hipMemsetAsync((char*)d_ws + WS_CTL, 0, CTL_ZERO_BYTES, stream) != hipSuccess) { fprintf(stderr, "kernel_launch: hipMemsetAsync failed\n"); return; }
    Args a{};
    for (int i = 0; i < 16; ++i) a.in[i] = (const float*)d_in[i];
    a.out = (float*)d_out; a.ws = (unsigned char*)d_ws; a.ph_lo = 0; a.ph_hi = N_PHASES;
    void* kargs[] = {(void*)&a};
    const hipError_t e = hipLaunchCooperativeKernel((const void*)fwd_kernel, dim3(grid), dim3(NWAVES * 64), kargs, LDS_BYTES, stream);
    if (e != hipSuccess) fprintf(stderr, "kernel_launch: cooperative launch failed: %s (grid %d)\n", hipGetErrorString(e), grid);
}
```
